# Optimizing an MI355X kernel written in HIP

```python
import math
import jax, jax.numpy as jnp
from jax import lax
import numpy as np

D_MODEL = 2048
BATCH = 16
SEQ = 256
DEPTH = 1
DEC_BATCH = 2
DEC_SEQ = 2048
PAST_LEN = 512

GRID_W = 64
SSM_WIDTH = D_MODEL // 2
SSM_GROUP = 16
SSM_GROUPS = SSM_WIDTH // SSM_GROUP
SSM_STATE = 64
N_HEADS = 16
HEAD_DIM = 64
ATT_WIDTH = N_HEADS * HEAD_DIM
WIN_ROWS = 8
WIN_COLS = 16
KEY_COLS = 2 * WIN_COLS
N_COL_BLOCKS = GRID_W // WIN_COLS
Q_BLOCK = 128
IN_WIDTH = 2 * SSM_WIDTH + 4 * ATT_WIDTH + 2 * D_MODEL
EPS = 1e-6
NEG_INF = -1e30

kernel_name = 'hybrid_s5_natten_prefix_dit_step'


def _rms(x, w):
    xf = x.astype(jnp.float32)
    y = xf * lax.rsqrt(jnp.mean(xf * xf, axis=-1, keepdims=True) + EPS)
    return (y * w.astype(jnp.float32)).astype(x.dtype)


def _modulation(cond, w_ada, b_ada):
    mod = jax.nn.silu(cond) @ w_ada + b_ada
    shift, scale, gate = jnp.split(mod[:, None, :], 3, axis=-1)
    return shift, scale, gate


def _front(x, shift, scale, norm_w, w_in, q_norm_w, k_norm_w):
    h = _rms(x, norm_w) * (1 + scale) + shift
    proj = h @ w_in
    cuts = [SSM_WIDTH, 2 * SSM_WIDTH, 2 * SSM_WIDTH + ATT_WIDTH, 2 * SSM_WIDTH + 2 * ATT_WIDTH,
            2 * SSM_WIDTH + 3 * ATT_WIDTH, 2 * SSM_WIDTH + 4 * ATT_WIDTH,
            2 * SSM_WIDTH + 4 * ATT_WIDTH + D_MODEL]
    u, z_s, q, k, v, z_a, g_s, g_a = jnp.split(proj, cuts, axis=-1)
    n, L, _ = x.shape
    q = _rms(q.reshape(n, L, N_HEADS, HEAD_DIM), q_norm_w)
    k = _rms(k.reshape(n, L, N_HEADS, HEAD_DIM), k_norm_w)
    v = v.reshape(n, L, N_HEADS, HEAD_DIM)
    return u, z_s, q, k, v, z_a, g_s, g_a


def _s5_discretize(a_re, a_im, log_dt, b_re, b_im):
    f32 = jnp.float32
    lam = lax.complex(jnp.minimum(a_re.astype(f32), -1e-4), a_im.astype(f32))
    dt = jnp.exp(log_dt.astype(f32))[..., None]
    lam_bar = jnp.exp(lam * dt)
    b = lax.complex(b_re.astype(f32), b_im.astype(f32))
    b_bar = ((lam_bar - 1) / lam)[..., None] * b
    return lam_bar, b_bar


def _lin_scan(bu, lam_bar, h0):
    bu = bu.at[:, 0].add(lam_bar * h0)
    a = jnp.broadcast_to(lam_bar, bu.shape)

    def combine(e1, e2):
        a1, b1 = e1
        a2, b2 = e2
        return a1 * a2, a2 * b1 + b2

    _, h = lax.associative_scan(combine, (a, bu), axis=1)
    return h


def _s5_bidir(u, lam_bar, b_bar, c_re, c_im, d, h0_f, h0_b):
    n, L, _ = u.shape
    f32 = jnp.float32
    uf = u.astype(f32)
    ug = uf.reshape(n, L, SSM_GROUPS, SSM_GROUP).astype(jnp.complex64)
    c = lax.complex(c_re.astype(f32), c_im.astype(f32))
    bu_f = jnp.einsum('blgi,gpi->blgp', ug, b_bar[0])
    bu_b = jnp.einsum('blgi,gpi->blgp', ug, b_bar[1])
    h_f = _lin_scan(bu_f, lam_bar[0], h0_f)
    h_b = jnp.flip(_lin_scan(jnp.flip(bu_b, axis=1), lam_bar[1], h0_b), axis=1)
    y = (jnp.einsum('blgp,gip->blgi', h_f, c[0]) + jnp.einsum('blgp,gip->blgi', h_b, c[1])).real
    y = y.reshape(n, L, SSM_WIDTH) + d.astype(f32) * uf
    return y, h_f[:, -1], h_b[:, 0]


def _context_attention(q, k, v):
    n, L, H, Dh = q.shape
    nblk = L // Q_BLOCK
    qb = q.reshape(n, nblk, Q_BLOCK, H, Dh).transpose(1, 0, 2, 3, 4)

    def block(qi):
        s = jnp.einsum('bqhd,bkhd->bhqk', qi, k).astype(jnp.float32) * (HEAD_DIM ** -0.5)
        p = jax.nn.softmax(s, axis=-1).astype(v.dtype)
        return jnp.einsum('bhqk,bkhd->bqhd', p, v)

    o = lax.map(block, qb)
    return o.transpose(1, 0, 2, 3, 4).reshape(n, L, H * Dh)


def _neighbourhood_attention(q, k, v, k_ctx, v_ctx, rpb):
    n, L, H, Dh = q.shape
    rows = L // GRID_W
    kh = min(WIN_ROWS, rows)
    qg = q.reshape(n, rows, GRID_W, H, Dh)
    kg = k.reshape(n, rows, GRID_W, H, Dh)
    vg = v.reshape(n, rows, GRID_W, H, Dh)
    jb = np.arange(N_COL_BLOCKS)
    col_start = np.clip(jb * WIN_COLS - WIN_COLS // 2, 0, GRID_W - KEY_COLS)
    col_idx = (col_start[:, None] + np.arange(KEY_COLS)[None, :]).astype(np.int32)
    q_col = jb[:, None] * WIN_COLS + np.arange(WIN_COLS)[None, :]
    cs = np.clip(q_col - WIN_COLS // 2, 0, GRID_W - WIN_COLS)
    kc = col_idx[:, None, :]
    mask = (kc >= cs[..., None]) & (kc < cs[..., None] + WIN_COLS)
    dc_idx = np.clip(kc - q_col[..., None] + WIN_COLS - 1, 0, 2 * WIN_COLS - 2).astype(np.int32)
    rpb32 = rpb.astype(jnp.float32)
    scale = HEAD_DIM ** -0.5

    def row_fn(r):
        rs = jnp.clip(r - kh // 2, 0, rows - kh)
        k_rows = lax.dynamic_slice_in_dim(kg, rs, kh, axis=1)
        v_rows = lax.dynamic_slice_in_dim(vg, rs, kh, axis=1)
        k_blk = k_rows[:, :, col_idx]
        v_blk = v_rows[:, :, col_idx]
        q_r = lax.dynamic_index_in_dim(qg, r, axis=1, keepdims=False)
        q_r = q_r.reshape(n, N_COL_BLOCKS, WIN_COLS, H, Dh)
        s_win = jnp.einsum('bjqhd,bkjmhd->bjqhkm', q_r, k_blk).astype(jnp.float32) * scale
        dr_idx = rs + jnp.arange(kh) - r + WIN_ROWS - 1
        bias = rpb32[:, dr_idx[:, None, None, None], dc_idx[None]]
        bias = bias.transpose(2, 3, 0, 1, 4)
        s_win = jnp.where(mask[:, :, None, None, :], s_win + bias, NEG_INF)
        s_ctx = jnp.einsum('bjqhd,bchd->bjqhc', q_r, k_ctx).astype(jnp.float32) * scale
        nw = kh * KEY_COLS
        s = jnp.concatenate([s_win.reshape(n, N_COL_BLOCKS, WIN_COLS, H, nw), s_ctx], axis=-1)
        p = jax.nn.softmax(s, axis=-1)
        p_win = p[..., :nw].reshape(n, N_COL_BLOCKS, WIN_COLS, H, kh, KEY_COLS).astype(v.dtype)
        p_ctx = p[..., nw:].astype(v_ctx.dtype)
        o = (jnp.einsum('bjqhkm,bkjmhd->bjqhd', p_win, v_blk)
             + jnp.einsum('bjqhc,bchd->bjqhd', p_ctx, v_ctx))
        return o.reshape(n, GRID_W, H * Dh)

    out = lax.map(row_fn, jnp.arange(rows))
    return out.transpose(1, 0, 2, 3).reshape(n, L, H * Dh)


def _back(x, y_ssm, z_s, attn, z_a, g_s, g_a, gate, w_glu, b_glu, w_ssm_out, w_att_out, w_o):
    ys = jax.nn.gelu(y_ssm.astype(x.dtype))
    ys = ys * jax.nn.sigmoid(ys @ w_glu + b_glu)
    ys = ys * jax.nn.silu(z_s)
    p_s = ys @ w_ssm_out
    p_a = (attn * jax.nn.silu(z_a)) @ w_att_out
    merged = jax.nn.sigmoid(g_s) * p_s + jax.nn.sigmoid(g_a) * p_a
    return x + gate * (merged @ w_o)


def setup_inputs(seed: int = 0) -> dict:
    key = jax.random.key(seed)
    ks = jax.random.split(key, 32)
    f32 = jnp.float32

    def nrm(k, shape, s):
        return jax.random.normal(k, shape, f32) * s

    L = DEPTH
    G, P, GC = SSM_GROUPS, SSM_STATE, SSM_GROUP
    n_idx = jnp.arange(P, dtype=f32)
    return {
        'x_prompt': nrm(ks[0], (BATCH, SEQ, D_MODEL), 1.0),
        'x_sample': nrm(ks[1], (DEC_BATCH, DEC_SEQ, D_MODEL), 1.0),
        'cache_k': nrm(ks[2], (DEC_BATCH, L, PAST_LEN, N_HEADS, HEAD_DIM), 1.0),
        'cache_v': nrm(ks[3], (DEC_BATCH, L, PAST_LEN, N_HEADS, HEAD_DIM), 1.0),
        'state_ssm_re': nrm(ks[4], (DEC_BATCH, L, 2, G, P), 0.5),
        'state_ssm_im': nrm(ks[5], (DEC_BATCH, L, 2, G, P), 0.5),
        'c': nrm(ks[6], (DEC_BATCH, D_MODEL), 1.0),
        'c_ctx': nrm(ks[7], (D_MODEL,), 1.0),
        'norm_w': 1.0 + nrm(ks[8], (L, D_MODEL), 0.02),
        'w_ada': nrm(ks[9], (L, D_MODEL, 3 * D_MODEL), 0.5 * D_MODEL ** -0.5),
        'b_ada': nrm(ks[10], (L, 3 * D_MODEL), 0.02),
        'w_in': nrm(ks[11], (L, D_MODEL, IN_WIDTH), D_MODEL ** -0.5),
        'q_norm_w': 1.0 + nrm(ks[12], (L, HEAD_DIM), 0.02),
        'k_norm_w': 1.0 + nrm(ks[13], (L, HEAD_DIM), 0.02),
        'rel_pos_bias': nrm(ks[14], (L, N_HEADS, 2 * WIN_ROWS - 1, 2 * WIN_COLS - 1), 0.02),
        'ssm_a_re': -0.5 + nrm(ks[15], (L, 2, G, P), 0.01),
        'ssm_a_im': jnp.pi * n_idx + nrm(ks[16], (L, 2, G, P), 0.01),
        'ssm_log_dt': jax.random.uniform(ks[17], (L, 2, G), f32, math.log(1e-3), math.log(1e-1)),
        'ssm_b_re': nrm(ks[18], (L, 2, G, P, GC), (2 * GC) ** -0.5),
        'ssm_b_im': nrm(ks[19], (L, 2, G, P, GC), (2 * GC) ** -0.5),
        'ssm_c_re': nrm(ks[20], (L, 2, G, GC, P), (2 * P) ** -0.5),
        'ssm_c_im': nrm(ks[21], (L, 2, G, GC, P), (2 * P) ** -0.5),
        'ssm_d': nrm(ks[22], (L, SSM_WIDTH), 1.0),
        'w_glu': nrm(ks[23], (L, SSM_WIDTH, SSM_WIDTH), SSM_WIDTH ** -0.5),
        'b_glu': nrm(ks[24], (L, SSM_WIDTH), 0.02),
        'w_ssm_out': nrm(ks[25], (L, SSM_WIDTH, D_MODEL), SSM_WIDTH ** -0.5),
        'w_att_out': nrm(ks[26], (L, ATT_WIDTH, D_MODEL), ATT_WIDTH ** -0.5),
        'w_o': nrm(ks[27], (L, D_MODEL, D_MODEL), D_MODEL ** -0.5),
    }


def reference(x_prompt, x_sample, cache_k, cache_v, state_ssm_re, state_ssm_im, c, c_ctx,
              norm_w, w_ada, b_ada, w_in, q_norm_w, k_norm_w, rel_pos_bias,
              ssm_a_re, ssm_a_im, ssm_log_dt, ssm_b_re, ssm_b_im, ssm_c_re, ssm_c_im, ssm_d,
              w_glu, b_glu, w_ssm_out, w_att_out, w_o):
    f32 = jnp.float32
    xp = x_prompt
    xs = x_sample
    new_k, new_v, new_re, new_im = [], [], [], []
    for l in range(DEPTH):
        lam_bar, b_bar = _s5_discretize(ssm_a_re[l], ssm_a_im[l], ssm_log_dt[l], ssm_b_re[l], ssm_b_im[l])

        shift, scale, gate = _modulation(c_ctx[None, :], w_ada[l], b_ada[l])
        u, z_s, q, k, v, z_a, g_s, g_a = _front(xp, shift, scale, norm_w[l], w_in[l], q_norm_w[l], k_norm_w[l])
        h0 = jnp.zeros((xp.shape[0], SSM_GROUPS, SSM_STATE), jnp.complex64)
        y_ssm, hf, hb = _s5_bidir(u, lam_bar, b_bar, ssm_c_re[l], ssm_c_im[l], ssm_d[l], h0, h0)
        attn = _context_attention(q, k, v)
        h_last = jnp.stack([hf, hb], axis=1)
        new_k.append(k)
        new_v.append(v)
        new_re.append(h_last.real)
        new_im.append(h_last.imag)
        xp = _back(xp, y_ssm, z_s, attn, z_a, g_s, g_a, gate,
                   w_glu[l], b_glu[l], w_ssm_out[l], w_att_out[l], w_o[l])

        shift, scale, gate = _modulation(c, w_ada[l], b_ada[l])
        u, z_s, q, k, v, z_a, g_s, g_a = _front(xs, shift, scale, norm_w[l], w_in[l], q_norm_w[l], k_norm_w[l])
        st = lax.complex(state_ssm_re[:, l].astype(f32), state_ssm_im[:, l].astype(f32))
        y_ssm, _, _ = _s5_bidir(u, lam_bar, b_bar, ssm_c_re[l], ssm_c_im[l], ssm_d[l], st[:, 0], st[:, 1])
        attn = _neighbourhood_attention(q, k, v, cache_k[:, l], cache_v[:, l], rel_pos_bias[l])
        xs = _back(xs, y_ssm, z_s, attn, z_a, g_s, g_a, gate,
                   w_glu[l], b_glu[l], w_ssm_out[l], w_att_out[l], w_o[l])

    new_cache_k = jnp.stack(new_k, axis=1)
    new_cache_v = jnp.stack(new_v, axis=1)
    new_state_re = jnp.stack(new_re, axis=1)
    new_state_im = jnp.stack(new_im, axis=1)
    return (xp, xs, new_cache_k, new_cache_v, new_state_re, new_state_im)
```

```cpp
#include <hip/hip_runtime.h>
#include <cstdio>
#include <cstdint>

#ifndef MK_N_LAUNCHES
#define MK_N_LAUNCHES 1
#endif

#define GAS __attribute__((address_space(1)))
#define LAS __attribute__((address_space(3)))
typedef unsigned short bf16_t;
typedef short bf16x8 __attribute__((ext_vector_type(8)));
typedef short s16x4 __attribute__((ext_vector_type(4)));
typedef float f32x4 __attribute__((ext_vector_type(4)));
typedef float f32x16 __attribute__((ext_vector_type(16)));
typedef unsigned u32x4 __attribute__((ext_vector_type(4)));
typedef unsigned u32x2 __attribute__((ext_vector_type(2)));
typedef float f32x2_t __attribute__((ext_vector_type(2)));
typedef __bf16 bf16x2_t __attribute__((ext_vector_type(2)));

constexpr int DM = 2048, NTOK = 8192, NPROMPT = 4096, INW = 10240, SSMW = 1024, ATTW = 1024, NH = 16, HD = 64;
constexpr int NGRP = 64, NSTATE = 64, TCH = 16;
constexpr float EPSN = 1e-6f;
constexpr float LOG2E = 1.4426950408889634f;
constexpr float QSCALE = 0.125f * LOG2E;

constexpr size_t MiB = 1u << 20;
constexpr size_t WS_CTL = 0, CTL_ZERO_BYTES = 1 * MiB;
constexpr size_t WS_MOD = 1 * MiB;
constexpr size_t WS_WIN = 2 * MiB;
constexpr size_t WS_A2 = 2 * MiB;
constexpr size_t WS_WGLU = 42 * MiB;
constexpr size_t WS_WM = 44 * MiB;
constexpr size_t WS_WO = 52 * MiB;
constexpr size_t WS_WA = 60 * MiB;
constexpr size_t WS_WOS = 68 * MiB;
constexpr size_t WS_CK = 84 * MiB, WS_CV = 86 * MiB;
constexpr size_t WS_XN = 88 * MiB;
constexpr size_t WS_S = 88 * MiB;
constexpr size_t WS_UH = 120 * MiB;
constexpr size_t WS_MG = 120 * MiB;
constexpr size_t WS_ZS = 152 * MiB;
constexpr size_t WS_Q = 168 * MiB;
constexpr size_t WS_YS = 168 * MiB;
constexpr size_t WS_KB = 184 * MiB, WS_VB = 200 * MiB, WS_ZA = 216 * MiB;
constexpr size_t WS_GS = 232 * MiB, WS_GA = 264 * MiB;
constexpr size_t WS_END = 296 * MiB;

constexpr size_t OUT_Y = 0, OUT_CK = 16777216, OUT_CV = 20971520, OUT_SRE = 25165824, OUT_SIM = 25296896, OUT_TOTAL = 25427968;

constexpr int RING_BYTES = 131072;
constexpr int XCH_OFF = RING_BYTES;
constexpr int MISC_OFF = RING_BYTES + 8192;
constexpr int LDS_BYTES = 147456;

constexpr int NWAVES = 8;

__device__ __forceinline__ unsigned cvtpk(float lo, float hi) { f32x2_t v = {lo, hi}; bf16x2_t b = __builtin_convertvector(v, bf16x2_t); return __builtin_bit_cast(unsigned, b); }
__device__ __forceinline__ float bf2f(unsigned short h) { return __builtin_bit_cast(float, (unsigned)h << 16); }
__device__ __forceinline__ float bflo(unsigned w) { return __builtin_bit_cast(float, w << 16); }
__device__ __forceinline__ float bfhi(unsigned w) { return __builtin_bit_cast(float, w & 0xffff0000u); }
__device__ __forceinline__ float sigm_f(float x) { return __builtin_amdgcn_rcpf(1.f + __builtin_amdgcn_exp2f(-LOG2E * x)); }
__device__ __forceinline__ float silu_f(float x) { return x * sigm_f(x); }
__device__ __forceinline__ float gelu_f(float x) { return x * sigm_f(1.5957691216057308f * (x + 0.044715f * x * x * x)); }
__device__ __forceinline__ u32x4 pack8(f32x4 a, f32x4 b) { u32x4 w; w.x = cvtpk(a[0], a[1]); w.y = cvtpk(a[2], a[3]); w.z = cvtpk(b[0], b[1]); w.w = cvtpk(b[2], b[3]); return w; }
__device__ __forceinline__ void unpack8(u32x4 w, f32x4& a, f32x4& b) { a = (f32x4){bflo(w.x), bfhi(w.x), bflo(w.y), bfhi(w.y)}; b = (f32x4){bflo(w.z), bfhi(w.z), bflo(w.w), bfhi(w.w)}; }
__device__ __forceinline__ float wave_sum(float v) {
#pragma unroll
    for (int o = 1; o < 64; o <<= 1) v += __shfl_xor(v, o);
    return v;
}
__device__ __forceinline__ void sincos_rad(float x, float& s, float& c) {
    float rev = x * 0.15915494309189535f; rev -= __builtin_floorf(rev);
    s = __builtin_amdgcn_sinf(rev); c = __builtin_amdgcn_cosf(rev);
}
#define LDS_WAIT() asm volatile("s_waitcnt lgkmcnt(0)" ::: "memory")
#define VM_WAIT() asm volatile("s_waitcnt vmcnt(0)" ::: "memory")

namespace pg8 {
constexpr int BM = 256, BK = 64, HALF = 128, HTB = HALF * BK * 2, STAGE_BYTES = 8 * HTB, NXCD = 8, WGM = 8;
__host__ __device__ __forceinline__ int lds_byte(int r, int c) { const int st = (r >> 4) * 2 + (c >> 5), rr = r & 15, cc = c & 31, ob = rr * 64 + cc * 2; return st * 1024 + (ob ^ (((ob >> 9) & 1) << 5)); }
__host__ __device__ __forceinline__ void stage_rc(int b, int& R, int& C) { const int st = b / 1024, sb = b % 1024, swz = sb ^ (((sb >> 9) & 1) << 5); R = (st >> 1) * 16 + swz / 64; C = (st & 1) * 32 + (swz % 64) / 2; }
__host__ __device__ __forceinline__ int perm32(int rho) { const int n = rho >> 4, i = rho & 15; return 8 * (i >> 2) + 4 * n + (i & 3); }

struct Unit { int pm, pn; };
struct Gemm { const bf16_t* A; const bf16_t* Bt; int lda, ldb, K; };

struct StaticOrder {
    int nM, nN, nwg, G, c;
    __device__ void init(int nM_, int nN_, int G_, int c_) { nM = nM_; nN = nN_; nwg = nM * nN; G = G_; c = c_; }
    __device__ bool next(int i, Unit& u) const {
        const long L = (long)i * G + c; if (L >= nwg) return false;
        int wgid = (int)L; { const int q = nwg / NXCD, r = nwg % NXCD, xcd = wgid % NXCD, off = wgid / NXCD; wgid = (xcd < r ? xcd * (q + 1) : r * (q + 1) + (xcd - r) * q) + off; }
        const int nig = WGM * nN, gid = wgid / nig, fm = gid * WGM, gsz = (nM - fm) < WGM ? (nM - fm) : WGM;
        u.pm = fm + ((wgid % nig) % gsz); u.pn = (wgid % nig) / gsz; return true;
    }
};
struct SsmOrder {
    int G, c;
    __device__ bool next(int i, Unit& u) const { const int L = i * G + c; if (L >= 128) return false; u.pm = L; u.pn = L >> 1; return true; }
};

typedef f32x4 Acc[2][2][4][2];

template <class Epi, class Sched, bool ALIGN_EPI>
__device__ __forceinline__ void gemm_phase(LAS unsigned char* lds, const Gemm g, const Sched& S, const Epi& E) {
    const int tid = threadIdx.x, wid = __builtin_amdgcn_readfirstlane(tid >> 6), lane = tid & 63, wr = wid >> 2, wc = wid & 3, fr = lane & 15, fq = lane >> 4;
    const int K = g.K, nt = K / BK;
    unsigned voffA[2], voffB[2];
#pragma unroll
    for (int i = 0; i < 2; ++i) { int R, C; stage_rc(tid * 16 + i * 8192, R, C); const int Rb = (R & ~31) + perm32(R & 31);
        voffA[i] = (unsigned)(R * g.lda + C) * 2u; voffB[i] = (unsigned)(Rb * g.ldb + C) * 2u; }
    const size_t kstep = (size_t)(BK * 2);
    const size_t hA = (size_t)HALF * g.lda * 2, hB = (size_t)HALF * g.ldb * 2, tA = 2 * hA, tB = 2 * hB;
    const unsigned ldsw = (unsigned)wid * 1024u;
    const int aoff = lds_byte(wr * 64 + fr, fq * 8), boff = lds_byte(wc * 32 + fr, fq * 8);
#define PG8_SA(b, h) (((b) * 2 + (h)) * HTB)
#define PG8_SB(b, h) ((4 + (b) * 2 + (h)) * HTB)
#define PG8_STAGE(bufoff, gbase, voff) do { _Pragma("unroll") for (int _i = 0; _i < 2; ++_i) \
        __builtin_amdgcn_global_load_lds((const unsigned*)((const char*)(gbase) + (voff)[_i]), (LAS unsigned*)(lds + (bufoff) + ldsw + _i * 8192), 16, 0, 0); } while (0)
#define PG8_LDA(dst, b, h) do { _Pragma("unroll") for (int m = 0; m < 4; ++m) _Pragma("unroll") for (int k = 0; k < 2; ++k) dst[m][k] = *(const LAS bf16x8*)(lds + PG8_SA(b, h) + aoff + m * 2048 + k * 1024); } while (0)
#define PG8_LDB(dst, b, h) do { _Pragma("unroll") for (int n = 0; n < 2; ++n) _Pragma("unroll") for (int k = 0; k < 2; ++k) dst[n][k] = *(const LAS bf16x8*)(lds + PG8_SB(b, h) + boff + n * 2048 + k * 1024); } while (0)
#define PG8_MMA(ai, bj, At, Bt) do { __builtin_amdgcn_s_setprio(1); _Pragma("unroll") for (int m = 0; m < 4; ++m) _Pragma("unroll") for (int n = 0; n < 2; ++n) _Pragma("unroll") for (int k = 0; k < 2; ++k) \
        acc[ai][bj][m][n] = __builtin_amdgcn_mfma_f32_16x16x32_bf16(Bt[n][k], At[m][k], acc[ai][bj][m][n], 0, 0, 0); __builtin_amdgcn_s_setprio(0); } while (0)
#define PG8_WAIT_V(n) asm volatile("s_waitcnt vmcnt(" #n ")" ::: "memory")
#define PG8_WAIT_L(n) asm volatile("s_waitcnt lgkmcnt(" #n ")" ::: "memory")
#define PG8_BAR __builtin_amdgcn_s_barrier()
#define PG8_SCHED __builtin_amdgcn_sched_barrier(0)
    Unit cur, nxt; int ui = 0;
    if (!S.next(0, cur)) return;
    Acc acc;
#pragma unroll
    for (int a = 0; a < 2; ++a)
#pragma unroll
        for (int b = 0; b < 2; ++b)
#pragma unroll
            for (int m = 0; m < 4; ++m)
#pragma unroll
                for (int n = 0; n < 2; ++n) acc[a][b][m][n] = (f32x4){0.f, 0.f, 0.f, 0.f};
    bf16x8 At[4][2], B0[2][2], B1[2][2];
    const char* cA = (const char*)g.A + (size_t)cur.pm * tA; const char* cB = (const char*)g.Bt + (size_t)cur.pn * tB;
    PG8_STAGE(PG8_SB(0, 0), cB, voffB); PG8_STAGE(PG8_SB(0, 1), cB + hB, voffB); PG8_STAGE(PG8_SA(0, 0), cA, voffA); PG8_STAGE(PG8_SA(0, 1), cA + hA, voffA);
    if (wr == 1) PG8_BAR;
    PG8_WAIT_V(2); PG8_BAR;
    PG8_STAGE(PG8_SB(1, 0), cB + kstep, voffB); PG8_STAGE(PG8_SA(1, 0), cA + kstep, voffA); PG8_STAGE(PG8_SB(1, 1), cB + hB + kstep, voffB);
    PG8_WAIT_V(6); PG8_BAR;
    for (;;) {
        const bool has_next = S.next(ui + 1, nxt);
        const char* nA = has_next ? (const char*)g.A + (size_t)nxt.pm * tA : cA; const char* nB = has_next ? (const char*)g.Bt + (size_t)nxt.pn * tB : cB;
        for (int t = 0; t < nt; t += 2) {
            const bool last = (t == nt - 2);
            const char* a1 = cA + (size_t)(t + 1) * kstep;
            const char* a2 = last ? nA : cA + (size_t)(t + 2) * kstep; const char* b2 = last ? nB : cB + (size_t)(t + 2) * kstep;
            const char* a3 = a2 + kstep; const char* b3 = b2 + kstep;
            if constexpr (Epi::MIDK) { if (t == (nt >> 1)) E.mid(acc, cur, wr, wc, fr, fq); }
            PG8_LDB(B0, 0, 0); PG8_LDB(B1, 0, 1); PG8_SCHED; PG8_LDA(At, 0, 0); PG8_STAGE(PG8_SA(1, 1), a1 + hA, voffA);
            PG8_WAIT_V(8); PG8_WAIT_L(0); PG8_BAR; PG8_MMA(0, 0, At, B0); PG8_MMA(0, 1, At, B1); PG8_BAR; PG8_SCHED;
            PG8_LDA(At, 0, 1); PG8_STAGE(PG8_SB(0, 0), b2, voffB); PG8_STAGE(PG8_SB(0, 1), b2 + hB, voffB); PG8_STAGE(PG8_SA(0, 0), a2, voffA);
            PG8_WAIT_V(8); PG8_WAIT_L(0); PG8_BAR; PG8_MMA(1, 0, At, B0); PG8_MMA(1, 1, At, B1); PG8_BAR; PG8_SCHED;
            PG8_LDB(B0, 1, 0); PG8_LDB(B1, 1, 1); PG8_SCHED; PG8_LDA(At, 1, 0); PG8_STAGE(PG8_SA(0, 1), a2 + hA, voffA);
            PG8_WAIT_V(8); PG8_WAIT_L(0); PG8_BAR; PG8_MMA(0, 0, At, B0); PG8_MMA(0, 1, At, B1); PG8_BAR; PG8_SCHED;
            PG8_LDA(At, 1, 1); PG8_STAGE(PG8_SB(1, 0), b3, voffB); PG8_STAGE(PG8_SB(1, 1), b3 + hB, voffB); PG8_STAGE(PG8_SA(1, 0), a3, voffA);
            PG8_WAIT_V(8); PG8_WAIT_L(0); PG8_BAR; PG8_MMA(1, 0, At, B0); PG8_MMA(1, 1, At, B1); PG8_BAR; PG8_SCHED;
        }
        if constexpr (ALIGN_EPI) { if (wr == 0) PG8_BAR; }
        E(acc, cur, wr, wc, fr, fq);
        if (!has_next) break;
#pragma unroll
        for (int a = 0; a < 2; ++a)
#pragma unroll
            for (int b = 0; b < 2; ++b)
#pragma unroll
                for (int m = 0; m < 4; ++m)
#pragma unroll
                    for (int n = 0; n < 2; ++n) acc[a][b][m][n] = (f32x4){0.f, 0.f, 0.f, 0.f};
        cur = nxt; cA = nA; cB = nB; ++ui;
        if constexpr (ALIGN_EPI) { if (wr == 1) PG8_BAR; }
    }
    PG8_WAIT_V(0);
    if constexpr (!ALIGN_EPI) { if (wr == 0) PG8_BAR; }
    PG8_BAR;
#undef PG8_SA
#undef PG8_SB
#undef PG8_STAGE
#undef PG8_LDA
#undef PG8_LDB
#undef PG8_MMA
#undef PG8_WAIT_V
#undef PG8_WAIT_L
#undef PG8_BAR
#undef PG8_SCHED
}
}

#define EPI_LOOP(ai, m, bj) _Pragma("unroll") for (int ai = 0; ai < 2; ++ai) _Pragma("unroll") for (int m = 0; m < 4; ++m) _Pragma("unroll") for (int bj = 0; bj < 2; ++bj)

struct EpiIn {
    static constexpr bool MIDK = false;
    bf16_t *UH, *ZS, *Q, *KB, *VB, *ZA, *GS, *GA; float *ock, *ocv; const float *qw, *kw; LAS float* xch;
    __device__ __forceinline__ void operator()(const pg8::Acc& acc, const pg8::Unit& u, int wr, int wc, int fr, int fq) const {
        const int type = u.pn >> 2;
        const int row0 = u.pm * 256 + wr * 64 + fr;
        const int col0 = u.pn * 256 + wc * 32 + 8 * fq;
        if (type == 0) {
            EPI_LOOP(ai, m, bj) { const int tok = row0 + ai * 128 + m * 16, c = col0 + bj * 128; const int g = c >> 4, i0 = c & 15;
                *(u32x4*)(UH + ((size_t)(g * 512 + (tok >> 4)) * 512 + (tok & 15) * 16 + i0)) = pack8(acc[ai][bj][m][0], acc[ai][bj][m][1]); }
        } else if (type == 1 || type == 5) {
            bf16_t* O = (type == 1) ? ZS : ZA; const int cb = (type == 1) ? 1024 : 5120;
            EPI_LOOP(ai, m, bj) { const int tok = row0 + ai * 128 + m * 16, c = col0 + bj * 128 - cb; f32x4 a = acc[ai][bj][m][0], b = acc[ai][bj][m][1];
#pragma unroll
                for (int e = 0; e < 4; ++e) { a[e] = silu_f(a[e]); b[e] = silu_f(b[e]); }
                *(u32x4*)(O + (size_t)tok * 1024 + c) = pack8(a, b); }
        } else if (type >= 6) {
            bf16_t* O = (type < 8) ? GS : GA; const int cb = (type < 8) ? 6144 : 8192;
            EPI_LOOP(ai, m, bj) { const int tok = row0 + ai * 128 + m * 16, c = col0 + bj * 128 - cb; f32x4 a = acc[ai][bj][m][0], b = acc[ai][bj][m][1];
#pragma unroll
                for (int e = 0; e < 4; ++e) { a[e] = sigm_f(a[e]); b[e] = sigm_f(b[e]); }
                *(u32x4*)(O + (size_t)tok * 2048 + c) = pack8(a, b); }
        } else if (type == 4) {
            EPI_LOOP(ai, m, bj) { const int tok = row0 + ai * 128 + m * 16, c = col0 + bj * 128 - 4096; const f32x4 a = acc[ai][bj][m][0], b = acc[ai][bj][m][1];
                *(u32x4*)(VB + (size_t)tok * 1024 + c) = pack8(a, b);
                if (tok < NPROMPT) { *(f32x4*)(ocv + (size_t)tok * 1024 + c) = a; *(f32x4*)(ocv + (size_t)tok * 1024 + c + 4) = b; } }
        } else {
            float ss[2][4][2];
            EPI_LOOP(ai, m, bj) { const f32x4 a = acc[ai][bj][m][0], b = acc[ai][bj][m][1];
                float s = (a[0] * a[0] + a[1] * a[1]) + (a[2] * a[2] + a[3] * a[3]) + (b[0] * b[0] + b[1] * b[1]) + (b[2] * b[2] + b[3] * b[3]);
                s += __shfl_xor(s, 16); s += __shfl_xor(s, 32); ss[ai][m][bj] = s;
                if (fq == 0) xch[(ai * 128 + wr * 64 + m * 16 + fr) * 8 + bj * 4 + wc] = s; }
            LDS_WAIT(); __builtin_amdgcn_s_barrier(); asm volatile("" ::: "memory");
            const float* nw = (type == 2) ? qw : kw; const float osc = (type == 2) ? QSCALE : 1.0f;
            const int d0 = (wc & 1) * 32 + 8 * fq;
            const f32x4 w0 = *(const f32x4*)(nw + d0), w1 = *(const f32x4*)(nw + d0 + 4);
            bf16_t* O = (type == 2) ? Q : KB; const int cb = (type == 2) ? 2048 : 3072;
            EPI_LOOP(ai, m, bj) { const int tok = row0 + ai * 128 + m * 16, c = col0 + bj * 128 - cb;
                const float tot = ss[ai][m][bj] + xch[(ai * 128 + wr * 64 + m * 16 + fr) * 8 + bj * 4 + (wc ^ 1)];
                const float rstd = __builtin_amdgcn_rsqf(tot * (1.0f / 64.0f) + EPSN);
                f32x4 a = acc[ai][bj][m][0] * rstd * w0, b = acc[ai][bj][m][1] * rstd * w1;
                if (type == 3 && tok < NPROMPT) { *(f32x4*)(ock + (size_t)tok * 1024 + c) = a; *(f32x4*)(ock + (size_t)tok * 1024 + c + 4) = b; }
                a = a * osc; b = b * osc;
                *(u32x4*)(O + (size_t)tok * 1024 + c) = pack8(a, b); }
        }
    }
};

struct EpiS {
    static constexpr bool MIDK = false;
    float* S;
    __device__ __forceinline__ void operator()(const pg8::Acc& acc, const pg8::Unit& u, int wr, int wc, int fr, int fq) const {
        const int row0 = u.pm * 256 + wr * 64 + fr, col0 = wc * 32 + 8 * fq;
        EPI_LOOP(ai, m, bj) { float* p = S + (size_t)(row0 + ai * 128 + m * 16) * 256 + col0 + bj * 128; *(f32x4*)p = acc[ai][bj][m][0]; *(f32x4*)(p + 4) = acc[ai][bj][m][1]; }
    }
};
struct EpiY {
    static constexpr bool MIDK = false;
    bf16_t* YS;
    __device__ __forceinline__ void operator()(const pg8::Acc& acc, const pg8::Unit& u, int wr, int wc, int fr, int fq) const {
        const int g = u.pm >> 1, ch0 = (u.pm & 1) * 256 + wr * 64 + fr, col0 = wc * 32 + 8 * fq;
        EPI_LOOP(ai, m, bj) { const int chunk = ch0 + ai * 128 + m * 16, c = col0 + bj * 128, tau = c >> 4, i0 = c & 15; f32x4 a = acc[ai][bj][m][0], b = acc[ai][bj][m][1];
#pragma unroll
            for (int e = 0; e < 4; ++e) { a[e] = gelu_f(a[e]); b[e] = gelu_f(b[e]); }
            *(u32x4*)(YS + (size_t)(chunk * 16 + tau) * 1024 + g * 16 + i0) = pack8(a, b); }
    }
};
struct EpiGlu {
    static constexpr bool MIDK = false;
    const bf16_t *YS, *ZS; const float* bglu; bf16_t* A2;
    __device__ __forceinline__ void operator()(const pg8::Acc& acc, const pg8::Unit& u, int wr, int wc, int fr, int fq) const {
        const int row0 = u.pm * 256 + wr * 64 + fr, col0 = u.pn * 256 + wc * 32 + 8 * fq;
        EPI_LOOP(ai, m, bj) { const int tok = row0 + ai * 128 + m * 16, c = col0 + bj * 128;
            const f32x4 b0 = *(const f32x4*)(bglu + c), b1 = *(const f32x4*)(bglu + c + 4);
            f32x4 y0, y1, z0, z1; unpack8(*(const u32x4*)(YS + (size_t)tok * 1024 + c), y0, y1); unpack8(*(const u32x4*)(ZS + (size_t)tok * 1024 + c), z0, z1);
            f32x4 a = acc[ai][bj][m][0] + b0, b = acc[ai][bj][m][1] + b1;
#pragma unroll
            for (int e = 0; e < 4; ++e) { a[e] = y0[e] * sigm_f(a[e]) * z0[e]; b[e] = y1[e] * sigm_f(b[e]) * z1[e]; }
            *(u32x4*)(A2 + (size_t)tok * 2048 + c) = pack8(a, b); }
    }
};
struct EpiMerge {
    static constexpr bool MIDK = true;
    const bf16_t *GS, *GA; bf16_t* MG;
    __device__ __forceinline__ void mid(pg8::Acc& acc, const pg8::Unit& u, int wr, int wc, int fr, int fq) const {
        int row0 = u.pm * 256 + wr * 64 + fr, col0 = u.pn * 256 + wc * 32 + 8 * fq;
        asm volatile("" : "+v"(row0), "+v"(col0));
        EPI_LOOP(ai, m, bj) { const size_t off = (size_t)(row0 + ai * 128 + m * 16) * 2048 + col0 + bj * 128;
            f32x4 s0, s1, a0, a1; unpack8(*(const u32x4*)(GS + off), s0, s1); unpack8(*(const u32x4*)(GA + off), a0, a1);
#pragma unroll
            for (int e = 0; e < 4; ++e) { acc[ai][bj][m][0][e] *= s0[e] * __builtin_amdgcn_rcpf(__builtin_fmaxf(a0[e], 1e-30f)); acc[ai][bj][m][1][e] *= s1[e] * __builtin_amdgcn_rcpf(__builtin_fmaxf(a1[e], 1e-30f)); }
            asm volatile("" : "+v"(acc[ai][bj][m][0]), "+v"(acc[ai][bj][m][1]) :: "memory"); }
    }
    __device__ __forceinline__ void operator()(const pg8::Acc& acc, const pg8::Unit& u, int wr, int wc, int fr, int fq) const {
        const int row0 = u.pm * 256 + wr * 64 + fr, col0 = u.pn * 256 + wc * 32 + 8 * fq;
        EPI_LOOP(ai, m, bj) { const size_t off = (size_t)(row0 + ai * 128 + m * 16) * 2048 + col0 + bj * 128;
            f32x4 a0, a1; unpack8(*(const u32x4*)(GA + off), a0, a1);
            *(u32x4*)(MG + off) = pack8(acc[ai][bj][m][0] * a0, acc[ai][bj][m][1] * a1); }
    }
};
struct EpiOut {
    static constexpr bool MIDK = false;
    const float *xp, *xs, *mod; float* out;
    __device__ __forceinline__ void operator()(const pg8::Acc& acc, const pg8::Unit& u, int wr, int wc, int fr, int fq) const {
        const int row0 = u.pm * 256 + wr * 64 + fr, col0 = u.pn * 256 + wc * 32 + 8 * fq;
        const int cond = (u.pm < 16) ? 0 : 1 + ((u.pm - 16) >> 3);
        const float* gate = mod + cond * 6144 + 4096;
        EPI_LOOP(ai, m, bj) { const int tok = row0 + ai * 128 + m * 16, c = col0 + bj * 128;
            const float* xr = (tok < NPROMPT) ? xp + (size_t)tok * 2048 : xs + (size_t)(tok - NPROMPT) * 2048;
            const f32x4 g0 = *(const f32x4*)(gate + c), g1 = *(const f32x4*)(gate + c + 4), x0 = *(const f32x4*)(xr + c), x1 = *(const f32x4*)(xr + c + 4);
            float* o = out + (size_t)tok * 2048 + c; *(f32x4*)o = x0 + g0 * acc[ai][bj][m][0]; *(f32x4*)(o + 4) = x1 + g1 * acc[ai][bj][m][1]; }
    }
};

#define XB_TMO      128
#define XB_XCNT(j)  (256  + 64 * (j))
#define XB_XSUB(j)  (1280 + 64 * (j))
#define XB_XGEN(j)  (2304 + 64 * (j))
#define XB_TOP      3328
#define XB_TOPGEN   3392
#define XCD_BAR_WORDS 3456
#define XB_SPIN_CAP (1u << 20)
__device__ __forceinline__ unsigned xb_ld(unsigned* p)              { return __hip_atomic_load(p, __ATOMIC_RELAXED, __HIP_MEMORY_SCOPE_AGENT); }
__device__ __forceinline__ unsigned xb_add(unsigned* p, unsigned v) { return __hip_atomic_fetch_add(p, v, __ATOMIC_RELAXED, __HIP_MEMORY_SCOPE_AGENT); }
__device__ __forceinline__ unsigned xb_xcc_id() { return (unsigned)__builtin_amdgcn_s_getreg((3 << 11) | 20) & 0xFu; }
#define XB_SPIN(cond, bar) do { unsigned _sp = 0; while (cond) { __builtin_amdgcn_s_sleep(1); \
    if ((++_sp & 255u) == 0u) { if (xb_ld(&(bar)[XB_TMO])) break; if (_sp > XB_SPIN_CAP) { atomicAdd(&(bar)[XB_TMO], 1u); break; } } } } while (0)
struct XcdBarrier { unsigned* bar; unsigned x; volatile LAS unsigned* st; };
__device__ __forceinline__ XcdBarrier xcd_barrier_post(unsigned* bar, volatile LAS unsigned* st) {
    XcdBarrier b; b.bar = bar; b.x = xb_xcc_id(); b.st = st;
    if (threadIdx.x == 0) (void)xb_add(&bar[XB_XCNT(b.x)], 1u);
    return b;
}
__device__ __forceinline__ void xcd_barrier_complete(unsigned* bar, unsigned x, unsigned& nloc, unsigned& nx) {
    const unsigned G = gridDim.x * gridDim.y * gridDim.z;
    unsigned sum, cnt, mine, sp = 0u;
    for (;;) {
        sum = 0u; cnt = 0u; mine = 0u;
#pragma unroll
        for (unsigned j = 0; j < 16; ++j) { const unsigned c = xb_ld(&bar[XB_XCNT(j)]); sum += c; cnt += (c > 0u) ? 1u : 0u; mine = (j == x) ? c : mine; }
        if (sum == G) break;
        __builtin_amdgcn_s_sleep(1);
        if ((++sp & 255u) == 0u) { if (xb_ld(&bar[XB_TMO])) break; if (sp > XB_SPIN_CAP) { atomicAdd(&bar[XB_TMO], 1u); break; } }
    }
    nloc = mine > 0u ? mine : 1u; nx = cnt > 0u ? cnt : 1u;
}
__device__ __forceinline__ void xcd_barrier(const XcdBarrier& b) {
    asm volatile("s_waitcnt vmcnt(0)" ::: "memory");
    __syncthreads();
    if (threadIdx.x == 0) {
        unsigned* bar = b.bar;
        __builtin_amdgcn_s_waitcnt(0);
        unsigned nloc = b.st[0], nx = b.st[1];
        if (nloc == 0u) { xcd_barrier_complete(bar, b.x, nloc, nx); b.st[0] = nloc; b.st[1] = nx; }
        const unsigned old = xb_add(&bar[XB_XSUB(b.x)], 1u);
        const unsigned gen = old / nloc;
        if (old + 1u == (gen + 1u) * nloc) {
            __builtin_amdgcn_fence(__ATOMIC_RELEASE, "agent");
            asm volatile("s_waitcnt vmcnt(0)" ::: "memory");
            const unsigned og = xb_add(&bar[XB_TOP], 1u);
            const unsigned tg = og / nx;
            if (og + 1u == (tg + 1u) * nx) xb_add(&bar[XB_TOPGEN], 1u);
            else XB_SPIN(xb_ld(&bar[XB_TOPGEN]) == tg, bar);
            __builtin_amdgcn_fence(__ATOMIC_ACQUIRE, "agent");
            xb_add(&bar[XB_XGEN(b.x)], 1u);
            asm volatile("s_waitcnt vmcnt(0)" ::: "memory");
        } else {
            XB_SPIN(xb_ld(&bar[XB_XGEN(b.x)]) == gen, bar);
            __builtin_amdgcn_fence(__ATOMIC_ACQUIRE, "agent");
            asm volatile("s_waitcnt vmcnt(0)" ::: "memory");
        }
    }
    __syncthreads();
}

struct Args { const float* in[28]; float* out; unsigned char* ws; int ph_lo, ph_hi; };
enum { I_XP = 0, I_XS, I_CK, I_CV, I_SRE, I_SIM, I_C, I_CCTX, I_NORMW, I_WADA, I_BADA, I_WIN, I_QNW, I_KNW, I_RPB, I_ARE, I_AIM, I_LOGDT, I_BRE, I_BIM, I_CRE, I_CIM, I_D, I_WGLU, I_BGLU, I_WSSM, I_WATT, I_WO };

__device__ __forceinline__ void p0_transpose_item(const float* W, int N, bf16_t* WT, int ldt, int koff, LAS float* scr, int item, int lane) {
    const int nblk = N / 32, kb = item / nblk, nb = item % nblk, k0 = 64 * kb, n0 = 32 * nb;
#pragma unroll 8
    for (int i = 0; i < 32; ++i) { const int kk = 2 * i + (lane >> 5); scr[kk * 33 + (lane & 31)] = W[(size_t)(k0 + kk) * N + n0 + (lane & 31)]; }
    LDS_WAIT(); asm volatile("" ::: "memory");
    const int c = lane & 7;
#pragma unroll
    for (int j = 0; j < 4; ++j) { const int n = (lane >> 3) + 8 * j; const LAS float* s = scr + (8 * c) * 33 + n;
        u32x4 o; o.x = cvtpk(s[0 * 33], s[1 * 33]); o.y = cvtpk(s[2 * 33], s[3 * 33]); o.z = cvtpk(s[4 * 33], s[5 * 33]); o.w = cvtpk(s[6 * 33], s[7 * 33]);
        *(u32x4*)(WT + (size_t)(n0 + n) * ldt + koff + k0 + 8 * c) = o; }
    LDS_WAIT(); asm volatile("" ::: "memory");
}

__device__ __forceinline__ void p0_ssm_prep(const Args& A, LAS float* sc, int g, int tid) {
    LAS float* LPr = sc;
    LAS float* LPi = sc + 2176;
    LAS float* BBr = sc + 4352;
    LAS float* BBi = sc + 6400;
    LAS float* CCr = sc + 8448;
    LAS float* CCi = sc + 10496;
    LAS float* KT = sc + 12544;
    LAS float* COr = sc + 20736;
    LAS float* COi = sc + 20864;
    const float* a_re = A.in[I_ARE]; const float* a_im = A.in[I_AIM]; const float* logdt = A.in[I_LOGDT];
    if (tid < 128) {
        const int d = tid >> 6, p = tid & 63;
        const float are = __builtin_fminf(a_re[(d * 64 + g) * 64 + p], -1e-4f), aim = a_im[(d * 64 + g) * 64 + p];
        const float dt = __expf(logdt[d * 64 + g]);
        const float zr = are * dt, zi = aim * dt;
#pragma unroll 1
        for (int e = 0; e <= 16; ++e) { float s, c; sincos_rad((float)e * zi, s, c); const float mg = __expf((float)e * zr); LPr[(d * 17 + e) * 64 + p] = mg * c; LPi[(d * 17 + e) * 64 + p] = mg * s; }
        float s1, c1, sh, chh; sincos_rad(zi, s1, c1); sincos_rad(0.5f * zi, sh, chh); (void)chh;
        const float em1 = expm1f(zr), mg = em1 + 1.0f;
        const float nr = em1 * c1 - 2.0f * sh * sh, ni = mg * s1;
        const float den = 1.0f / (are * are + aim * aim);
        COr[d * 64 + p] = (nr * are + ni * aim) * den; COi[d * 64 + p] = (ni * are - nr * aim) * den;
    }
    __syncthreads();
    {
        const float* b_re = A.in[I_BRE]; const float* b_im = A.in[I_BIM]; const float* c_re = A.in[I_CRE]; const float* c_im = A.in[I_CIM];
#pragma unroll
        for (int n = 0; n < 4; ++n) { const int idx = tid + 512 * n, d = idx >> 10, p = (idx >> 4) & 63, j = idx & 15;
            const float br = b_re[((size_t)(d * 64 + g) * 64 + p) * 16 + j], bi = b_im[((size_t)(d * 64 + g) * 64 + p) * 16 + j];
            const float cr = COr[d * 64 + p], ci = COi[d * 64 + p];
            BBr[idx] = cr * br - ci * bi; BBi[idx] = cr * bi + ci * br; }
#pragma unroll
        for (int n = 0; n < 4; ++n) { const int idx = tid + 512 * n, d = idx >> 10, i = (idx >> 6) & 15, p = idx & 63;
            CCr[(d * 64 + p) * 16 + i] = c_re[((size_t)(d * 64 + g) * 16 + i) * 64 + p]; CCi[(d * 64 + p) * 16 + i] = c_im[((size_t)(d * 64 + g) * 16 + i) * 64 + p]; }
    }
    __syncthreads();
    {
        const int d = tid >> 8, dl = (tid >> 4) & 15, i = tid & 15;
        float acc[16];
#pragma unroll
        for (int j = 0; j < 16; ++j) acc[j] = 0.f;
#pragma unroll 2
        for (int p = 0; p < 64; ++p) {
            const float cr = CCr[(d * 64 + p) * 16 + i], ci = CCi[(d * 64 + p) * 16 + i], lr = LPr[(d * 17 + dl) * 64 + p], li = LPi[(d * 17 + dl) * 64 + p];
            const float tr = cr * lr - ci * li, ti = cr * li + ci * lr;
            const LAS f32x4* br4 = (const LAS f32x4*)(BBr + (d * 64 + p) * 16); const LAS f32x4* bi4 = (const LAS f32x4*)(BBi + (d * 64 + p) * 16);
#pragma unroll
            for (int q = 0; q < 4; ++q) { const f32x4 br = br4[q], bi = bi4[q];
#pragma unroll
                for (int e = 0; e < 4; ++e) acc[q * 4 + e] += tr * br[e] - ti * bi[e]; }
        }
#pragma unroll
        for (int j = 0; j < 16; ++j) KT[(d * 16 + dl) * 256 + i * 16 + j] = acc[j];
    }
    __syncthreads();
    bf16_t* WA = (bf16_t*)(A.ws + WS_WA) + (size_t)g * 256 * 256;
    bf16_t* WOS = (bf16_t*)(A.ws + WS_WOS) + (size_t)g * 256 * 512;
#pragma unroll 1
    for (int it = 0; it < 16; ++it) {
        const int q = it * 512 + tid, n = q >> 5, s = (q >> 1) & 15, jh = q & 1, d = n >> 7, ri = (n >> 6) & 1, p = n & 63;
        const int e = (d == 0) ? 15 - s : s;
        const float lr = LPr[(d * 17 + e) * 64 + p], li = LPi[(d * 17 + e) * 64 + p];
        float v[8];
#pragma unroll
        for (int jj = 0; jj < 8; ++jj) { const float br = BBr[(d * 64 + p) * 16 + jh * 8 + jj], bi = BBi[(d * 64 + p) * 16 + jh * 8 + jj]; v[jj] = ri == 0 ? lr * br - li * bi : lr * bi + li * br; }
        u32x4 o; o.x = cvtpk(v[0], v[1]); o.y = cvtpk(v[2], v[3]); o.z = cvtpk(v[4], v[5]); o.w = cvtpk(v[6], v[7]);
        *(u32x4*)(WA + (size_t)n * 256 + s * 16 + jh * 8) = o;
    }
    const float* dsk = A.in[I_D];
#pragma unroll 1
    for (int it = 0; it < 32; ++it) {
        const int q = it * 512 + tid, n = q >> 6, pc = q & 63, tau = n >> 4, i = n & 15;
        float v[8];
        if (pc < 32) {
            const int s = pc >> 1, jh = pc & 1, dl = tau - s;
            if (dl > 0) {
#pragma unroll
                for (int jj = 0; jj < 8; ++jj) v[jj] = KT[(0 * 16 + dl) * 256 + i * 16 + jh * 8 + jj];
            } else if (dl < 0) {
#pragma unroll
                for (int jj = 0; jj < 8; ++jj) v[jj] = KT[(1 * 16 - dl) * 256 + i * 16 + jh * 8 + jj];
            } else {
                const float dv = dsk[g * 16 + i];
#pragma unroll
                for (int jj = 0; jj < 8; ++jj) v[jj] = KT[i * 16 + jh * 8 + jj] + KT[16 * 256 + i * 16 + jh * 8 + jj] + ((jh * 8 + jj) == i ? dv : 0.f);
            }
        } else {
            const int kk = (pc - 32) * 8, d = kk >> 7, ri = (kk >> 6) & 1, p0 = kk & 63, f = (d == 0) ? tau + 1 : 16 - tau;
#pragma unroll
            for (int jj = 0; jj < 8; ++jj) { const int p = p0 + jj; const float cr = CCr[(d * 64 + p) * 16 + i], ci = CCi[(d * 64 + p) * 16 + i], lr = LPr[(d * 17 + f) * 64 + p], li = LPi[(d * 17 + f) * 64 + p];
                v[jj] = ri == 0 ? cr * lr - ci * li : -(cr * li + ci * lr); }
        }
        u32x4 o; o.x = cvtpk(v[0], v[1]); o.y = cvtpk(v[2], v[3]); o.z = cvtpk(v[4], v[5]); o.w = cvtpk(v[6], v[7]);
        *(u32x4*)(WOS + (size_t)n * 512 + pc * 8) = o;
    }
    __syncthreads();
}

__device__ __forceinline__ void p0_gemv_strip(const Args& A, LAS float* sc, int s, int tid) {
    LAS float* cs = sc;
    LAS float* red = sc + 6144;
    const float* cctx = A.in[I_CCTX]; const float* c = A.in[I_C];
    for (int i = tid; i < 6144; i += 512) { const float v = (i < 2048) ? cctx[i] : c[i - 2048]; cs[i] = silu_f(v); }
    __syncthreads();
    const int wid = tid >> 6, lane = tid & 63, kk = lane >> 3, c4 = lane & 7;
    const float* W = A.in[I_WADA] + (size_t)(256 * wid + kk) * 6144 + 32 * s + 4 * c4;
    f32x4 a0 = {0.f, 0.f, 0.f, 0.f}, a1 = a0, a2 = a0;
#pragma unroll 8
    for (int it = 0; it < 32; ++it) { const f32x4 w = *(const f32x4*)(W + (size_t)it * 8 * 6144); const int k = 256 * wid + 8 * it + kk;
        a0 += cs[k] * w; a1 += cs[2048 + k] * w; a2 += cs[4096 + k] * w; }
#pragma unroll
    for (int e = 0; e < 4; ++e) {
#pragma unroll
        for (int o = 8; o < 64; o <<= 1) { a0[e] += __shfl_xor(a0[e], o); a1[e] += __shfl_xor(a1[e], o); a2[e] += __shfl_xor(a2[e], o); }
    }
    if (kk == 0) {
#pragma unroll
        for (int e = 0; e < 4; ++e) { red[(wid * 3 + 0) * 32 + c4 * 4 + e] = a0[e]; red[(wid * 3 + 1) * 32 + c4 * 4 + e] = a1[e]; red[(wid * 3 + 2) * 32 + c4 * 4 + e] = a2[e]; }
    }
    __syncthreads();
    if (tid < 96) { const int cnd = tid >> 5, col = tid & 31; float v = A.in[I_BADA][32 * s + col];
#pragma unroll
        for (int w = 0; w < 8; ++w) v += red[(w * 3 + cnd) * 32 + col];
        ((float*)(A.ws + WS_MOD))[cnd * 6144 + 32 * s + col] = v; }
    __syncthreads();
}

__device__ __forceinline__ void phase0(const Args& A, LAS unsigned char* lds, int tid, int lane, int wave) {
    const int bx = blockIdx.x, G = gridDim.x;
    for (int t = bx; t < 256; t += G) {
        if (t < 64) p0_ssm_prep(A, (LAS float*)lds, t, tid);
        else p0_gemv_strip(A, (LAS float*)lds, t - 64, tid);
    }
    LAS float* scr = (LAS float*)(lds + wave * 16384);
    const int gw = bx * NWAVES + wave, NGW = G * NWAVES;
    constexpr int I_IN = 32 * 320, I_GLU = 16 * 32, I_SO = 16 * 64, I_AO = 16 * 64, I_O = 32 * 64, NITEMS = I_IN + I_GLU + I_SO + I_AO + I_O;
    for (int it = gw; it < NITEMS; it += NGW) {
        int r = it;
        if (r < I_IN) { p0_transpose_item(A.in[I_WIN], INW, (bf16_t*)(A.ws + WS_WIN), 2048, 0, scr, r, lane); continue; } r -= I_IN;
        if (r < I_GLU) { p0_transpose_item(A.in[I_WGLU], 1024, (bf16_t*)(A.ws + WS_WGLU), 1024, 0, scr, r, lane); continue; } r -= I_GLU;
        if (r < I_SO) { p0_transpose_item(A.in[I_WSSM], 2048, (bf16_t*)(A.ws + WS_WM), 2048, 0, scr, r, lane); continue; } r -= I_SO;
        if (r < I_AO) { p0_transpose_item(A.in[I_WATT], 2048, (bf16_t*)(A.ws + WS_WM), 2048, 1024, scr, r, lane); continue; } r -= I_AO;
        p0_transpose_item(A.in[I_WO], 2048, (bf16_t*)(A.ws + WS_WO), 2048, 0, scr, r, lane);
    }
    {
        const int gt = bx * 512 + tid, NT = G * 512;
        for (int i = gt; i < 2 * 131072; i += NT) {
            const int which = i >> 17, j = i & 131071;
            const float* src = A.in[which ? I_CV : I_CK] + (size_t)j * 8;
            const f32x4 a = *(const f32x4*)src, b = *(const f32x4*)(src + 4);
            *(u32x4*)((bf16_t*)(A.ws + (which ? WS_CV : WS_CK)) + (size_t)j * 8) = pack8(a, b);
        }
    }
}

__device__ __forceinline__ void phase1(const Args& A, int lane, int wave) {
    const int gw = blockIdx.x * NWAVES + wave, NGW = gridDim.x * NWAVES;
    const float* mod = (const float*)(A.ws + WS_MOD); const float* nw = A.in[I_NORMW];
    bf16_t* XN = (bf16_t*)(A.ws + WS_XN);
    for (int m = gw; m < NTOK; m += NGW) {
        const float* xr = (m < NPROMPT) ? A.in[I_XP] + (size_t)m * 2048 : A.in[I_XS] + (size_t)(m - NPROMPT) * 2048;
        const int cond = (m < NPROMPT) ? 0 : 1 + ((m - NPROMPT) >> 11);
        const float* sh = mod + cond * 6144; const float* scl = sh + 2048;
        f32x4 v[8]; float s = 0.f;
#pragma unroll
        for (int j = 0; j < 8; ++j) { v[j] = *(const f32x4*)(xr + 4 * lane + 256 * j); s += (v[j][0] * v[j][0] + v[j][1] * v[j][1]) + (v[j][2] * v[j][2] + v[j][3] * v[j][3]); }
        const float rstd = __builtin_amdgcn_rsqf(wave_sum(s) * (1.0f / 2048.0f) + EPSN);
#pragma unroll
        for (int j = 0; j < 8; ++j) { const int c = 4 * lane + 256 * j; const f32x4 w = *(const f32x4*)(nw + c), a = *(const f32x4*)(scl + c), b = *(const f32x4*)(sh + c);
            const f32x4 o = (v[j] * rstd * w) * (a + 1.0f) + b; u32x2 pk; pk.x = cvtpk(o[0], o[1]); pk.y = cvtpk(o[2], o[3]);
            *(u32x2*)(XN + (size_t)m * 2048 + c) = pk; }
    }
}

__device__ __forceinline__ void scan_task(const Args& A, int g, int seq  , int d, int lane) {
    const int p = lane;
    const float are = __builtin_fminf(A.in[I_ARE][(d * 64 + g) * 64 + p], -1e-4f), aim = A.in[I_AIM][(d * 64 + g) * 64 + p];
    const float dt = __expf(A.in[I_LOGDT][d * 64 + g]);
    float ls, lc; sincos_rad(16.0f * aim * dt, ls, lc); const float mg = __expf(16.0f * are * dt);
    const float lr = mg * lc, li = mg * ls;
    const bool smp = seq >= 16;
    const int nC = smp ? 128 : 16, chunk0 = smp ? 256 + 128 * (seq - 16) : 16 * seq;
    float hr = 0.f, hi = 0.f;
    if (smp) { const int sb = seq - 16; hr = A.in[I_SRE][((sb * 2 + d) * 64 + g) * 64 + p]; hi = A.in[I_SIM][((sb * 2 + d) * 64 + g) * 64 + p]; }
    const float* S = (const float*)(A.ws + WS_S) + (size_t)(g * 512 + chunk0) * 256 + d * 128 + p;
    bf16_t* H = (bf16_t*)(A.ws + WS_UH) + (size_t)(g * 512 + chunk0) * 512 + 256 + d * 128 + p;
    for (int i0 = 0; i0 < nC; i0 += 8) {
        float sr[8], si[8];
#pragma unroll
        for (int k = 0; k < 8; ++k) { const int c = (d == 0) ? i0 + k : nC - 1 - (i0 + k); sr[k] = S[(size_t)c * 256]; si[k] = S[(size_t)c * 256 + 64]; }
#pragma unroll
        for (int k = 0; k < 8; ++k) { const int c = (d == 0) ? i0 + k : nC - 1 - (i0 + k);
            H[(size_t)c * 512] = (bf16_t)(cvtpk(hr, 0.f) & 0xffffu); H[(size_t)c * 512 + 64] = (bf16_t)(cvtpk(hi, 0.f) & 0xffffu);
            const float nr = lr * hr - li * hi + sr[k], ni = lr * hi + li * hr + si[k]; hr = nr; hi = ni; }
    }
    if (!smp) { A.out[OUT_SRE + ((size_t)(seq * 2 + d) * 64 + g) * 64 + p] = hr; A.out[OUT_SIM + ((size_t)(seq * 2 + d) * 64 + g) * 64 + p] = hi; }
}
__device__ __forceinline__ void phase4(const Args& A, int lane, int wave) {
    const int gw = blockIdx.x * NWAVES + wave, NGW = gridDim.x * NWAVES;
    for (int t = gw; t < 2304; t += NGW) {
        if (t < 256) scan_task(A, t >> 2, 16 + ((t >> 1) & 1), t & 1, lane);
        else { const int q = t - 256; scan_task(A, q >> 5, (q >> 1) & 15, q & 1, lane); }
    }
}

namespace att {
constexpr int KB0 = 0, VB0 = 16384, WSF = 32768, STG = 34816, BIAS = 67584;
__device__ __forceinline__ int crow(int r, int hi) { return (r & 3) + 8 * (r >> 2) + 4 * hi; }
__device__ __forceinline__ s16x4 vtr(const LAS unsigned char* p) { return __builtin_bit_cast(s16x4, __builtin_amdgcn_ds_read_tr16_b64_v4i16((LAS s16x4*)p)); }

template <bool NA>
__device__ __forceinline__ void unit(const Args& A, LAS unsigned char* lds, int un, int tid) {
    const int lane = tid & 63, r32 = lane & 31, hi = lane >> 5, wid = __builtin_amdgcn_readfirstlane(tid >> 6);
    const bf16_t* Q = (const bf16_t*)(A.ws + WS_Q); const bf16_t* KBp = (const bf16_t*)(A.ws + WS_KB); const bf16_t* VBp = (const bf16_t*)(A.ws + WS_VB);
    const bf16_t* CK = (const bf16_t*)(A.ws + WS_CK); const bf16_t* CV = (const bf16_t*)(A.ws + WS_CV);
    const bf16_t* ZA = (const bf16_t*)(A.ws + WS_ZA); bf16_t* A2 = (bf16_t*)(A.ws + WS_A2);
    int b, h, NT, qtok0, r = 0, rs = 0, rlo = 0, half = 0;
    if (NA) { b = un >> 7; h = (un >> 3) & 15; const int R4 = un & 7; r = 4 * R4 + (wid >> 1); half = wid & 1; qtok0 = NPROMPT + b * 2048 + r * 64 + half * 32;
        rs = min(max(r - 4, 0), 24); rlo = min(max(4 * R4 - 4, 0), 24); const int rhi = min(max(4 * R4 - 1, 0), 24) + 7; NT = 8 + (rhi - rlo + 1); }
    else { b = un >> 4; h = un & 15; qtok0 = b * 256 + wid * 32; NT = 4; }
    LAS float* wsf = (LAS float*)(lds + WSF) + wid * 64;
    LAS float* bl = (LAS float*)(lds + BIAS);
    if (NA) { if (tid < 465) bl[tid] = A.in[I_RPB][h * 465 + tid] * LOG2E; }
    bf16x8 qr[4];
    { const bf16_t* qp = Q + (size_t)(qtok0 + r32) * 1024 + h * 64 + hi * 8;
#pragma unroll
      for (int d0 = 0; d0 < 4; ++d0) qr[d0] = *(const bf16x8*)(qp + d0 * 16); }
    const int krow = lane, kcol = wid * 8, vrow = 16 * (wid & 3) + (lane >> 2), vcol = (wid >> 2) * 32 + (lane & 3) * 8;
    auto tile_rows = [&](int t, const bf16_t*& kb, const bf16_t*& vb) {
        if (NA) { if (t < 8) { const size_t o = (size_t)(b * 512 + 64 * t) * 1024 + h * 64; kb = CK + o; vb = CV + o; }
                  else { const size_t o = (size_t)(NPROMPT + b * 2048 + (rlo + t - 8) * 64) * 1024 + h * 64; kb = KBp + o; vb = VBp + o; } }
        else { const size_t o = (size_t)(b * 256 + 64 * t) * 1024 + h * 64; kb = KBp + o; vb = VBp + o; }
    };
    u32x4 kreg, vreg;
    { const bf16_t *kb, *vb; tile_rows(0, kb, vb); kreg = *(const u32x4*)(kb + (size_t)krow * 1024 + kcol); vreg = *(const u32x4*)(vb + (size_t)vrow * 1024 + vcol); }
    float mrun = -1e30f, lrun = 0.f; f32x16 o0 = {}, o1 = {};
    const int qc = half * 32 + r32, cs = min(max(qc - 8, 0), 48);
#pragma unroll 1
    for (int t = 0; t < NT; ++t) {
        const int buf = t & 1;
        *(LAS u32x4*)(lds + KB0 + buf * 8192 + wid * 1024 + lane * 16) = kreg;
        *(LAS u32x4*)(lds + VB0 + buf * 8192 + wid * 1024 + lane * 16) = vreg;
        __syncthreads();
        if (t + 1 < NT) { const bf16_t *kb, *vb; tile_rows(t + 1, kb, vb); kreg = *(const u32x4*)(kb + (size_t)krow * 1024 + kcol); vreg = *(const u32x4*)(vb + (size_t)vrow * 1024 + vcol); }
        const int kr = rlo + t - 8;
        const bool active = !NA || t < 8 || (kr >= rs && kr < rs + 8);
        if (active) {
            f32x16 p0 = {}, p1 = {};
            { const LAS unsigned char* kb = lds + KB0 + buf * 8192 + hi * 1024 + r32 * 16;
#pragma unroll
              for (int d0 = 0; d0 < 4; ++d0) { const bf16x8 b0 = *(const LAS bf16x8*)(kb + d0 * 2048), b1 = *(const LAS bf16x8*)(kb + d0 * 2048 + 512);
                  p0 = __builtin_amdgcn_mfma_f32_32x32x16_bf16(b0, qr[d0], p0, 0, 0, 0); p1 = __builtin_amdgcn_mfma_f32_32x32x16_bf16(b1, qr[d0], p1, 0, 0, 0); } }
            if (NA && t >= 8) {
                const int dr = kr - r + 7; const LAS float* brow = bl + dr * 31 + 15 - qc;
#pragma unroll
                for (int rr = 0; rr < 16; ++rr) { const int kc = crow(rr, hi);
                    { const bool ok = (kc >= cs) && (kc < cs + 16); const int ix = min(max(kc - qc + 15, 0), 30); (void)brow; const float bv = bl[dr * 31 + ix]; p0[rr] = ok ? p0[rr] + bv : -1e30f; }
                    { const int kc2 = kc + 32; const bool ok = (kc2 >= cs) && (kc2 < cs + 16); const int ix = min(max(kc2 - qc + 15, 0), 30); const float bv = bl[dr * 31 + ix]; p1[rr] = ok ? p1[rr] + bv : -1e30f; } }
            }
            float mt = p0[0];
#pragma unroll
            for (int rr = 1; rr < 16; ++rr) mt = __builtin_fmaxf(mt, p0[rr]);
#pragma unroll
            for (int rr = 0; rr < 16; ++rr) mt = __builtin_fmaxf(mt, p1[rr]);
            mt = __builtin_fmaxf(mt, __shfl_xor(mt, 32));
            const float mnew = __builtin_fmaxf(mrun, mt);
            if (__any(mnew > mrun)) {
                const float alpha = __builtin_amdgcn_exp2f(mrun - mnew);
                lrun *= alpha; mrun = mnew;
                if (hi == 0) wsf[r32] = alpha;
                LDS_WAIT();
#pragma unroll
                for (int rr = 0; rr < 16; ++rr) { const float f = wsf[crow(rr, hi)]; o0[rr] *= f; o1[rr] *= f; }
            }
            float sacc = 0.f;
#pragma unroll
            for (int rr = 0; rr < 16; ++rr) { p0[rr] = __builtin_amdgcn_exp2f(p0[rr] - mrun); p1[rr] = __builtin_amdgcn_exp2f(p1[rr] - mrun); sacc += p0[rr] + p1[rr]; }
            lrun += sacc;
            u32x4 pw[4];
            pw[0] = (u32x4){cvtpk(p0[0], p0[1]), cvtpk(p0[2], p0[3]), cvtpk(p0[4], p0[5]), cvtpk(p0[6], p0[7])};
            pw[1] = (u32x4){cvtpk(p0[8], p0[9]), cvtpk(p0[10], p0[11]), cvtpk(p0[12], p0[13]), cvtpk(p0[14], p0[15])};
            pw[2] = (u32x4){cvtpk(p1[0], p1[1]), cvtpk(p1[2], p1[3]), cvtpk(p1[4], p1[5]), cvtpk(p1[6], p1[7])};
            pw[3] = (u32x4){cvtpk(p1[8], p1[9]), cvtpk(p1[10], p1[11]), cvtpk(p1[12], p1[13]), cvtpk(p1[14], p1[15])};
            const LAS unsigned char* vp = lds + VB0 + buf * 8192 + ((lane >> 4) & 1) * 32 + (lane & 3) * 8 + (4 * hi + ((lane & 15) >> 2)) * 64;
#pragma unroll
            for (int k = 0; k < 4; ++k) {
                const s16x4 l0 = vtr(vp + k * 1024), h0 = vtr(vp + k * 1024 + 512), l1 = vtr(vp + 4096 + k * 1024), h1 = vtr(vp + 4096 + k * 1024 + 512);
                const bf16x8 v0 = (bf16x8){l0[0], l0[1], l0[2], l0[3], h0[0], h0[1], h0[2], h0[3]}, v1 = (bf16x8){l1[0], l1[1], l1[2], l1[3], h1[0], h1[1], h1[2], h1[3]};
                const bf16x8 pa = __builtin_bit_cast(bf16x8, pw[k]);
                o0 = __builtin_amdgcn_mfma_f32_32x32x16_bf16(pa, v0, o0, 0, 0, 0); o1 = __builtin_amdgcn_mfma_f32_32x32x16_bf16(pa, v1, o1, 0, 0, 0);
            }
        }
    }
    const float ltot = lrun + __shfl_xor(lrun, 32);
    if (hi == 0) wsf[32 + r32] = ltot;
    LDS_WAIT();
    LAS bf16_t* stg = (LAS bf16_t*)(lds + STG) + wid * 2048;
#pragma unroll
    for (int rr = 0; rr < 16; ++rr) { const int orow = crow(rr, hi); const float rl = __builtin_amdgcn_rcpf(wsf[32 + orow]);
        stg[orow * 64 + r32] = (bf16_t)(cvtpk(o0[rr] * rl, 0.f) & 0xffffu); stg[orow * 64 + 32 + r32] = (bf16_t)(cvtpk(o1[rr] * rl, 0.f) & 0xffffu); }
    LDS_WAIT();
#pragma unroll
    for (int i = 0; i < 4; ++i) { const int row = i * 8 + (lane >> 3), ch = lane & 7; const u32x4 ov = *(const LAS u32x4*)(stg + row * 64 + ch * 8);
        const size_t tok = (size_t)(qtok0 + row);
        f32x4 a0, a1, z0, z1; unpack8(ov, a0, a1); unpack8(*(const u32x4*)(ZA + tok * 1024 + h * 64 + ch * 8), z0, z1);
        *(u32x4*)(A2 + tok * 2048 + 1024 + h * 64 + ch * 8) = pack8(a0 * z0, a1 * z1); }
    __syncthreads();
}
}

constexpr int NPHASE = 9;
__global__ void __launch_bounds__(NWAVES * 64, 2) fwd_kernel(Args args) {
    extern __shared__ __attribute__((aligned(16))) unsigned char lds_raw[];
    LAS unsigned char* lds = (LAS unsigned char*)lds_raw;
    volatile LAS unsigned* MISC = (volatile LAS unsigned*)(lds + MISC_OFF);
    const int tid = threadIdx.x, lane = tid & 63, wave = __builtin_amdgcn_readfirstlane(tid >> 6);
    const int G = gridDim.x;
    for (int u = tid; u < (LDS_BYTES - MISC_OFF) / 4; u += NWAVES * 64) ((LAS unsigned*)(lds + MISC_OFF))[u] = 0u;
    __syncthreads();
    unsigned* barw = (unsigned*)(args.ws + WS_CTL) + 4096;
    const int lo = args.ph_lo, hi = args.ph_hi;
    const bool one = (hi - lo) > 1;
    XcdBarrier bar; bar.bar = barw; bar.x = 0; bar.st = nullptr;
    if (one) bar = xcd_barrier_post(barw, MISC + 8);
#ifndef PHMASK
#define PHMASK 0x1ff
#endif
#define IN(k) (((PHMASK >> (k)) & 1) && lo <= (k) && (k) < hi)
#define SEAM(k) do { if (IN(k) && IN((k) + 1)) xcd_barrier(bar); } while (0)
    unsigned char* ws = args.ws;

    if (IN(0)) { phase0(args, lds, tid, lane, wave); SEAM(0); }
    if (IN(1)) { phase1(args, lane, wave); SEAM(1); }
    if (IN(2)) {
        pg8::Gemm g{(const bf16_t*)(ws + WS_XN), (const bf16_t*)(ws + WS_WIN), 2048, 2048, 2048};
        pg8::StaticOrder S; S.init(32, 40, G, (int)blockIdx.x);
        EpiIn E{(bf16_t*)(ws + WS_UH), (bf16_t*)(ws + WS_ZS), (bf16_t*)(ws + WS_Q), (bf16_t*)(ws + WS_KB), (bf16_t*)(ws + WS_VB), (bf16_t*)(ws + WS_ZA), (bf16_t*)(ws + WS_GS), (bf16_t*)(ws + WS_GA),
                args.out + OUT_CK, args.out + OUT_CV, args.in[I_QNW], args.in[I_KNW], (LAS float*)(lds + XCH_OFF)};
        pg8::gemm_phase<EpiIn, pg8::StaticOrder, true>(lds, g, S, E);
        SEAM(2);
    }
    if (IN(3)) {
        {
            pg8::Gemm g{(const bf16_t*)(ws + WS_UH), (const bf16_t*)(ws + WS_WA), 512, 256, 256};
            pg8::SsmOrder S{G, (int)blockIdx.x};
            EpiS E{(float*)(ws + WS_S)};
            pg8::gemm_phase<EpiS, pg8::SsmOrder, false>(lds, g, S, E);
        }
        for (int un = blockIdx.x; un < 256; un += G) att::unit<true>(args, lds, un, tid);
        for (int un = blockIdx.x; un < 256; un += G) att::unit<false>(args, lds, un, tid);
        SEAM(3);
    }
    if (IN(4)) { phase4(args, lane, wave); SEAM(4); }
    if (IN(5)) {
        pg8::Gemm g{(const bf16_t*)(ws + WS_UH), (const bf16_t*)(ws + WS_WOS), 512, 512, 512};
        pg8::SsmOrder S{G, (int)blockIdx.x};
        EpiY E{(bf16_t*)(ws + WS_YS)};
        pg8::gemm_phase<EpiY, pg8::SsmOrder, false>(lds, g, S, E);
        SEAM(5);
    }
    if (IN(6)) {
        pg8::Gemm g{(const bf16_t*)(ws + WS_YS), (const bf16_t*)(ws + WS_WGLU), 1024, 1024, 1024};
        pg8::StaticOrder S; S.init(32, 4, G, (int)blockIdx.x);
        EpiGlu E{(const bf16_t*)(ws + WS_YS), (const bf16_t*)(ws + WS_ZS), args.in[I_BGLU], (bf16_t*)(ws + WS_A2)};
        pg8::gemm_phase<EpiGlu, pg8::StaticOrder, false>(lds, g, S, E);
        SEAM(6);
    }
    if (IN(7)) {
        pg8::Gemm g{(const bf16_t*)(ws + WS_A2), (const bf16_t*)(ws + WS_WM), 2048, 2048, 2048};
        pg8::StaticOrder S; S.init(32, 8, G, (int)blockIdx.x);
        EpiMerge E{(const bf16_t*)(ws + WS_GS), (const bf16_t*)(ws + WS_GA), (bf16_t*)(ws + WS_MG)};
        pg8::gemm_phase<EpiMerge, pg8::StaticOrder, false>(lds, g, S, E);
        SEAM(7);
    }
    if (IN(8)) {
        pg8::Gemm g{(const bf16_t*)(ws + WS_MG), (const bf16_t*)(ws + WS_WO), 2048, 2048, 2048};
        pg8::StaticOrder S; S.init(32, 8, G, (int)blockIdx.x);
        EpiOut E{args.in[I_XP], args.in[I_XS], (const float*)(ws + WS_MOD), args.out + OUT_Y};
        pg8::gemm_phase<EpiOut, pg8::StaticOrder, false>(lds, g, S, E);
    }
#undef IN
#undef SEAM
}

extern "C" void kernel_launch(void* const* d_in, const int* in_sizes, int n_in, void* d_out, int out_size, void* d_ws, size_t ws_size, hipStream_t stream) {
    static int grid = 0;
    if (grid == 0) {
        if (n_in != 28 || out_size != (int)OUT_TOTAL || ws_size < WS_END) { fprintf(stderr, "kernel_launch: unexpected problem (n_in %d, out %d, ws %zu)\n", n_in, out_size, ws_size); grid = -1; return; }
        int dev = 0, cus = 0, per_cu = 0;
        if (hipGetDevice(&dev) != hipSuccess || hipDeviceGetAttribute(&cus, hipDeviceAttributeMultiprocessorCount, dev) != hipSuccess) { grid = -1; return; }
        if (hipFuncSetAttribute((const void*)fwd_kernel, hipFuncAttributeMaxDynamicSharedMemorySize, LDS_BYTES) != hipSuccess) { fprintf(stderr, "kernel_launch: hipFuncSetAttribute failed\n"); grid = -1; return; }
        if (hipOccupancyMaxActiveBlocksPerMultiprocessor(&per_cu, (const void*)fwd_kernel, NWAVES * 64, LDS_BYTES) != hipSuccess || per_cu < 1) { fprintf(stderr, "kernel_launch: occupancy query says %d\n", per_cu); per_cu = 1; }
        (void)hipGetLastError();
        grid = cus;
        fprintf(stderr, "kernel_launch: grid %d (cus %d, per_cu %d), ws %zu\n", grid, cus, per_cu, ws_size);
    }
    if (grid < 0) return;
    (void)hipMemsetAsync((char*)d_ws + WS_CTL, 0, CTL_ZERO_BYTES, stream);
    Args a{};
    for (int i = 0; i < 28; ++i) a.in[i] = (const float*)d_in[i];
    a.out = (float*)d_out; a.ws = (unsigned char*)d_ws;
#if MK_N_LAUNCHES == 1
    a.ph_lo = 0; a.ph_hi = NPHASE;
    void* params[] = {&a};
    hipError_t e = hipLaunchCooperativeKernel((const void*)fwd_kernel, dim3(grid), dim3(NWAVES * 64), params, LDS_BYTES, stream);
    if (e != hipSuccess) fprintf(stderr, "kernel_launch: cooperative launch failed: %s\n", hipGetErrorString(e));
#else
    for (int p = 0; p < NPHASE; ++p) {
        a.ph_lo = p; a.ph_hi = p + 1;
        hipLaunchKernelGGL(fwd_kernel, dim3(grid), dim3(NWAVES * 64), LDS_BYTES, stream, a);
    }
#endif
}
```

```cpp
#include <hip/hip_runtime.h>
#include <cstdio>
#include <cstdint>

#ifndef MK_N_LAUNCHES
#define MK_N_LAUNCHES 1
#endif

#define GAS __attribute__((address_space(1)))
#define LAS __attribute__((address_space(3)))
typedef unsigned short bf16_t;
typedef short bf16x8 __attribute__((ext_vector_type(8)));
typedef short s16x4 __attribute__((ext_vector_type(4)));
typedef float f32x4 __attribute__((ext_vector_type(4)));
typedef float f32x16 __attribute__((ext_vector_type(16)));
typedef unsigned u32x4 __attribute__((ext_vector_type(4)));
typedef unsigned u32x2 __attribute__((ext_vector_type(2)));
typedef float f32x2_t __attribute__((ext_vector_type(2)));
typedef __bf16 bf16x2_t __attribute__((ext_vector_type(2)));

constexpr int DM = 2048, NTOK = 8192, NPROMPT = 4096, INW = 10240, SSMW = 1024, ATTW = 1024, NH = 16, HD = 64;
constexpr int NGRP = 64, NSTATE = 64, TCH = 16;
constexpr float EPSN = 1e-6f;
constexpr float LOG2E = 1.4426950408889634f;
constexpr float QSCALE = 0.125f * LOG2E;

constexpr size_t MiB = 1u << 20;
constexpr size_t WS_CTL = 0, CTL_ZERO_BYTES = 1 * MiB;
constexpr size_t WS_MOD = 1 * MiB;
constexpr size_t WS_WIN = 2 * MiB;
constexpr size_t WS_A2 = 2 * MiB;
constexpr size_t WS_WGLU = 42 * MiB;
constexpr size_t WS_WM = 44 * MiB;
constexpr size_t WS_WO = 52 * MiB;
constexpr size_t WS_WA = 60 * MiB;
constexpr size_t WS_WOS = 68 * MiB;
constexpr size_t WS_CK = 84 * MiB, WS_CV = 86 * MiB;
constexpr size_t WS_XN = 88 * MiB;
constexpr size_t WS_S = 88 * MiB;
constexpr size_t WS_UH = 120 * MiB;
constexpr size_t WS_MG = 120 * MiB;
constexpr size_t WS_ZS = 152 * MiB;
constexpr size_t WS_Q = 168 * MiB;
constexpr size_t WS_YS = 168 * MiB;
constexpr size_t WS_KB = 184 * MiB, WS_VB = 200 * MiB, WS_ZA = 216 * MiB;
constexpr size_t WS_GS = 232 * MiB, WS_GA = 264 * MiB;
constexpr size_t WS_END = 296 * MiB;

constexpr size_t OUT_Y = 0, OUT_CK = 16777216, OUT_CV = 20971520, OUT_SRE = 25165824, OUT_SIM = 25296896, OUT_TOTAL = 25427968;

constexpr int RING_BYTES = 131072;
constexpr int XCH_OFF = RING_BYTES;
constexpr int MISC_OFF = RING_BYTES + 8192;
constexpr int LDS_BYTES = 147456;

constexpr int NWAVES = 8;

__device__ __forceinline__ unsigned cvtpk(float lo, float hi) { f32x2_t v = {lo, hi}; bf16x2_t b = __builtin_convertvector(v, bf16x2_t); return __builtin_bit_cast(unsigned, b); }
__device__ __forceinline__ float bf2f(unsigned short h) { return __builtin_bit_cast(float, (unsigned)h << 16); }
__device__ __forceinline__ float bflo(unsigned w) { return __builtin_bit_cast(float, w << 16); }
__device__ __forceinline__ float bfhi(unsigned w) { return __builtin_bit_cast(float, w & 0xffff0000u); }
__device__ __forceinline__ float sigm_f(float x) { return __builtin_amdgcn_rcpf(1.f + __builtin_amdgcn_exp2f(-LOG2E * x)); }
__device__ __forceinline__ float silu_f(float x) { return x * sigm_f(x); }
__device__ __forceinline__ float gelu_f(float x) { return x * sigm_f(1.5957691216057308f * (x + 0.044715f * x * x * x)); }
__device__ __forceinline__ u32x4 pack8(f32x4 a, f32x4 b) { u32x4 w; w.x = cvtpk(a[0], a[1]); w.y = cvtpk(a[2], a[3]); w.z = cvtpk(b[0], b[1]); w.w = cvtpk(b[2], b[3]); return w; }
__device__ __forceinline__ void unpack8(u32x4 w, f32x4& a, f32x4& b) { a = (f32x4){bflo(w.x), bfhi(w.x), bflo(w.y), bfhi(w.y)}; b = (f32x4){bflo(w.z), bfhi(w.z), bflo(w.w), bfhi(w.w)}; }
__device__ __forceinline__ float wave_sum(float v) {
#pragma unroll
    for (int o = 1; o < 64; o <<= 1) v += __shfl_xor(v, o);
    return v;
}
__device__ __forceinline__ void sincos_rad(float x, float& s, float& c) {
    float rev = x * 0.15915494309189535f; rev -= __builtin_floorf(rev);
    s = __builtin_amdgcn_sinf(rev); c = __builtin_amdgcn_cosf(rev);
}
#define LDS_WAIT() asm volatile("s_waitcnt lgkmcnt(0)" ::: "memory")
#define VM_WAIT() asm volatile("s_waitcnt vmcnt(0)" ::: "memory")

namespace pg8 {
constexpr int BM = 256, BK = 64, HALF = 128, HTB = HALF * BK * 2, STAGE_BYTES = 8 * HTB, NXCD = 8, WGM = 8;
__host__ __device__ __forceinline__ int lds_byte(int r, int c) { const int st = (r >> 4) * 2 + (c >> 5), rr = r & 15, cc = c & 31, ob = rr * 64 + cc * 2; return st * 1024 + (ob ^ (((ob >> 9) & 1) << 5)); }
__host__ __device__ __forceinline__ void stage_rc(int b, int& R, int& C) { const int st = b / 1024, sb = b % 1024, swz = sb ^ (((sb >> 9) & 1) << 5); R = (st >> 1) * 16 + swz / 64; C = (st & 1) * 32 + (swz % 64) / 2; }
__host__ __device__ __forceinline__ int perm32(int rho) { const int n = rho >> 4, i = rho & 15; return 8 * (i >> 2) + 4 * n + (i & 3); }

struct Unit { int pm, pn; };
struct Gemm { const bf16_t* A; const bf16_t* Bt; int lda, ldb, K; };

struct StaticOrder {
    int nM, nN, nwg, G, c, rep;
    __device__ void init(int nM_, int nN_, int G_, int c_, int rep_ = 1) { nM = nM_; nN = nN_; nwg = nM * nN; G = G_; c = c_; rep = rep_; }
    __device__ bool next(int i, Unit& u) const {
        long L = (long)i * G + c; if (L >= (long)nwg * rep) return false; if (L >= nwg) L -= nwg;
        int wgid = (int)L; { const int q = nwg / NXCD, r = nwg % NXCD, xcd = wgid % NXCD, off = wgid / NXCD; wgid = (xcd < r ? xcd * (q + 1) : r * (q + 1) + (xcd - r) * q) + off; }
        const int nig = WGM * nN, gid = wgid / nig, fm = gid * WGM, gsz = (nM - fm) < WGM ? (nM - fm) : WGM;
        u.pm = fm + ((wgid % nig) % gsz); u.pn = (wgid % nig) / gsz; return true;
    }
};
struct SsmOrder {
    int G, c, rep;
    __device__ bool next(int i, Unit& u) const { int L = i * G + c; if (L >= 128 * rep) return false; L &= 127; u.pm = L; u.pn = L >> 1; return true; }
};

typedef f32x4 Acc[2][2][4][2];

template <class Epi, class Sched, bool ALIGN_EPI>
__device__ __forceinline__ void gemm_phase(LAS unsigned char* lds, const Gemm g, const Sched& S, const Epi& E) {
    const int tid = threadIdx.x, wid = __builtin_amdgcn_readfirstlane(tid >> 6), lane = tid & 63, wr = wid >> 2, wc = wid & 3, fr = lane & 15, fq = lane >> 4;
    const int K = g.K, nt = K / BK;
    unsigned voffA[2], voffB[2];
#pragma unroll
    for (int i = 0; i < 2; ++i) { int R, C; stage_rc(tid * 16 + i * 8192, R, C); const int Rb = (R & ~31) + perm32(R & 31);
        voffA[i] = (unsigned)(R * g.lda + C) * 2u; voffB[i] = (unsigned)(Rb * g.ldb + C) * 2u; }
    const size_t kstep = (size_t)(BK * 2);
    const size_t hA = (size_t)HALF * g.lda * 2, hB = (size_t)HALF * g.ldb * 2, tA = 2 * hA, tB = 2 * hB;
    const unsigned ldsw = (unsigned)wid * 1024u;
    const int aoff = lds_byte(wr * 64 + fr, fq * 8), boff = lds_byte(wc * 32 + fr, fq * 8);
#define PG8_SA(b, h) (((b) * 2 + (h)) * HTB)
#define PG8_SB(b, h) ((4 + (b) * 2 + (h)) * HTB)
#define PG8_STAGE(bufoff, gbase, voff) do { _Pragma("unroll") for (int _i = 0; _i < 2; ++_i) \
        __builtin_amdgcn_global_load_lds((const unsigned*)((const char*)(gbase) + (voff)[_i]), (LAS unsigned*)(lds + (bufoff) + ldsw + _i * 8192), 16, 0, 0); } while (0)
#define PG8_LDA(dst, b, h) do { _Pragma("unroll") for (int m = 0; m < 4; ++m) _Pragma("unroll") for (int k = 0; k < 2; ++k) dst[m][k] = *(const LAS bf16x8*)(lds + PG8_SA(b, h) + aoff + m * 2048 + k * 1024); } while (0)
#define PG8_LDB(dst, b, h) do { _Pragma("unroll") for (int n = 0; n < 2; ++n) _Pragma("unroll") for (int k = 0; k < 2; ++k) dst[n][k] = *(const LAS bf16x8*)(lds + PG8_SB(b, h) + boff + n * 2048 + k * 1024); } while (0)
#define PG8_MMA(ai, bj, At, Bt) do { __builtin_amdgcn_s_setprio(1); _Pragma("unroll") for (int m = 0; m < 4; ++m) _Pragma("unroll") for (int n = 0; n < 2; ++n) _Pragma("unroll") for (int k = 0; k < 2; ++k) \
        acc[ai][bj][m][n] = __builtin_amdgcn_mfma_f32_16x16x32_bf16(Bt[n][k], At[m][k], acc[ai][bj][m][n], 0, 0, 0); __builtin_amdgcn_s_setprio(0); } while (0)
#define PG8_WAIT_V(n) asm volatile("s_waitcnt vmcnt(" #n ")" ::: "memory")
#define PG8_WAIT_L(n) asm volatile("s_waitcnt lgkmcnt(" #n ")" ::: "memory")
#define PG8_BAR __builtin_amdgcn_s_barrier()
#define PG8_SCHED __builtin_amdgcn_sched_barrier(0)
    Unit cur, nxt; int ui = 0;
    if (!S.next(0, cur)) return;
    Acc acc;
#pragma unroll
    for (int a = 0; a < 2; ++a)
#pragma unroll
        for (int b = 0; b < 2; ++b)
#pragma unroll
            for (int m = 0; m < 4; ++m)
#pragma unroll
                for (int n = 0; n < 2; ++n) acc[a][b][m][n] = (f32x4){0.f, 0.f, 0.f, 0.f};
    bf16x8 At[4][2], B0[2][2], B1[2][2];
    const char* cA = (const char*)g.A + (size_t)cur.pm * tA; const char* cB = (const char*)g.Bt + (size_t)cur.pn * tB;
    PG8_STAGE(PG8_SB(0, 0), cB, voffB); PG8_STAGE(PG8_SB(0, 1), cB + hB, voffB); PG8_STAGE(PG8_SA(0, 0), cA, voffA); PG8_STAGE(PG8_SA(0, 1), cA + hA, voffA);
    if (wr == 1) PG8_BAR;
    PG8_WAIT_V(2); PG8_BAR;
    PG8_STAGE(PG8_SB(1, 0), cB + kstep, voffB); PG8_STAGE(PG8_SA(1, 0), cA + kstep, voffA); PG8_STAGE(PG8_SB(1, 1), cB + hB + kstep, voffB);
    PG8_WAIT_V(6); PG8_BAR;
    for (;;) {
        const bool has_next = S.next(ui + 1, nxt);
        const char* nA = has_next ? (const char*)g.A + (size_t)nxt.pm * tA : cA; const char* nB = has_next ? (const char*)g.Bt + (size_t)nxt.pn * tB : cB;
        for (int t = 0; t < nt; t += 2) {
            const bool last = (t == nt - 2);
            const char* a1 = cA + (size_t)(t + 1) * kstep;
            const char* a2 = last ? nA : cA + (size_t)(t + 2) * kstep; const char* b2 = last ? nB : cB + (size_t)(t + 2) * kstep;
            const char* a3 = a2 + kstep; const char* b3 = b2 + kstep;
            if constexpr (Epi::MIDK) { if (t == (nt >> 1)) E.mid(acc, cur, wr, wc, fr, fq); }
            PG8_LDB(B0, 0, 0); PG8_LDB(B1, 0, 1); PG8_SCHED; PG8_LDA(At, 0, 0); PG8_STAGE(PG8_SA(1, 1), a1 + hA, voffA);
            PG8_WAIT_V(8); PG8_WAIT_L(0); PG8_BAR; PG8_MMA(0, 0, At, B0); PG8_MMA(0, 1, At, B1); PG8_BAR; PG8_SCHED;
            PG8_LDA(At, 0, 1); PG8_STAGE(PG8_SB(0, 0), b2, voffB); PG8_STAGE(PG8_SB(0, 1), b2 + hB, voffB); PG8_STAGE(PG8_SA(0, 0), a2, voffA);
            PG8_WAIT_V(8); PG8_WAIT_L(0); PG8_BAR; PG8_MMA(1, 0, At, B0); PG8_MMA(1, 1, At, B1); PG8_BAR; PG8_SCHED;
            PG8_LDB(B0, 1, 0); PG8_LDB(B1, 1, 1); PG8_SCHED; PG8_LDA(At, 1, 0); PG8_STAGE(PG8_SA(0, 1), a2 + hA, voffA);
            PG8_WAIT_V(8); PG8_WAIT_L(0); PG8_BAR; PG8_MMA(0, 0, At, B0); PG8_MMA(0, 1, At, B1); PG8_BAR; PG8_SCHED;
            PG8_LDA(At, 1, 1); PG8_STAGE(PG8_SB(1, 0), b3, voffB); PG8_STAGE(PG8_SB(1, 1), b3 + hB, voffB); PG8_STAGE(PG8_SA(1, 0), a3, voffA);
            PG8_WAIT_V(8); PG8_WAIT_L(0); PG8_BAR; PG8_MMA(1, 0, At, B0); PG8_MMA(1, 1, At, B1); PG8_BAR; PG8_SCHED;
        }
        if constexpr (ALIGN_EPI) { if (wr == 0) PG8_BAR; }
        E(acc, cur, wr, wc, fr, fq);
        if (!has_next) break;
#pragma unroll
        for (int a = 0; a < 2; ++a)
#pragma unroll
            for (int b = 0; b < 2; ++b)
#pragma unroll
                for (int m = 0; m < 4; ++m)
#pragma unroll
                    for (int n = 0; n < 2; ++n) acc[a][b][m][n] = (f32x4){0.f, 0.f, 0.f, 0.f};
        cur = nxt; cA = nA; cB = nB; ++ui;
        if constexpr (ALIGN_EPI) { if (wr == 1) PG8_BAR; }
    }
    PG8_WAIT_V(0);
    if constexpr (!ALIGN_EPI) { if (wr == 0) PG8_BAR; }
    PG8_BAR;
#undef PG8_SA
#undef PG8_SB
#undef PG8_STAGE
#undef PG8_LDA
#undef PG8_LDB
#undef PG8_MMA
#undef PG8_WAIT_V
#undef PG8_WAIT_L
#undef PG8_BAR
#undef PG8_SCHED
}
}

#define EPI_LOOP(ai, m, bj) _Pragma("unroll") for (int ai = 0; ai < 2; ++ai) _Pragma("unroll") for (int m = 0; m < 4; ++m) _Pragma("unroll") for (int bj = 0; bj < 2; ++bj)

struct EpiIn {
    static constexpr bool MIDK = false;
    bf16_t *UH, *ZS, *Q, *KB, *VB, *ZA, *GS, *GA; float *ock, *ocv; const float *qw, *kw; LAS float* xch;
    __device__ __forceinline__ void operator()(const pg8::Acc& acc, const pg8::Unit& u, int wr, int wc, int fr, int fq) const {
        const int type = u.pn >> 2;
        const int row0 = u.pm * 256 + wr * 64 + fr;
        const int col0 = u.pn * 256 + wc * 32 + 8 * fq;
        if (type == 0) {
            EPI_LOOP(ai, m, bj) { const int tok = row0 + ai * 128 + m * 16, c = col0 + bj * 128; const int g = c >> 4, i0 = c & 15;
                *(u32x4*)(UH + ((size_t)(g * 512 + (tok >> 4)) * 512 + (tok & 15) * 16 + i0)) = pack8(acc[ai][bj][m][0], acc[ai][bj][m][1]); }
        } else if (type == 1 || type == 5) {
            bf16_t* O = (type == 1) ? ZS : ZA; const int cb = (type == 1) ? 1024 : 5120;
            EPI_LOOP(ai, m, bj) { const int tok = row0 + ai * 128 + m * 16, c = col0 + bj * 128 - cb; f32x4 a = acc[ai][bj][m][0], b = acc[ai][bj][m][1];
#pragma unroll
                for (int e = 0; e < 4; ++e) { a[e] = silu_f(a[e]); b[e] = silu_f(b[e]); }
                *(u32x4*)(O + (size_t)tok * 1024 + c) = pack8(a, b); }
        } else if (type >= 6) {
            bf16_t* O = (type < 8) ? GS : GA; const int cb = (type < 8) ? 6144 : 8192;
            EPI_LOOP(ai, m, bj) { const int tok = row0 + ai * 128 + m * 16, c = col0 + bj * 128 - cb; f32x4 a = acc[ai][bj][m][0], b = acc[ai][bj][m][1];
#pragma unroll
                for (int e = 0; e < 4; ++e) { a[e] = sigm_f(a[e]); b[e] = sigm_f(b[e]); }
                *(u32x4*)(O + (size_t)tok * 2048 + c) = pack8(a, b); }
        } else if (type == 4) {
            EPI_LOOP(ai, m, bj) { const int tok = row0 + ai * 128 + m * 16, c = col0 + bj * 128 - 4096; const f32x4 a = acc[ai][bj][m][0], b = acc[ai][bj][m][1];
                *(u32x4*)(VB + (size_t)tok * 1024 + c) = pack8(a, b);
                if (tok < NPROMPT) { *(f32x4*)(ocv + (size_t)tok * 1024 + c) = a; *(f32x4*)(ocv + (size_t)tok * 1024 + c + 4) = b; } }
        } else {
            float ss[2][4][2];
            EPI_LOOP(ai, m, bj) { const f32x4 a = acc[ai][bj][m][0], b = acc[ai][bj][m][1];
                float s = (a[0] * a[0] + a[1] * a[1]) + (a[2] * a[2] + a[3] * a[3]) + (b[0] * b[0] + b[1] * b[1]) + (b[2] * b[2] + b[3] * b[3]);
                s += __shfl_xor(s, 16); s += __shfl_xor(s, 32); ss[ai][m][bj] = s;
                if (fq == 0) xch[(ai * 128 + wr * 64 + m * 16 + fr) * 8 + bj * 4 + wc] = s; }
            LDS_WAIT(); __builtin_amdgcn_s_barrier(); asm volatile("" ::: "memory");
            const float* nw = (type == 2) ? qw : kw; const float osc = (type == 2) ? QSCALE : 1.0f;
            const int d0 = (wc & 1) * 32 + 8 * fq;
            const f32x4 w0 = *(const f32x4*)(nw + d0), w1 = *(const f32x4*)(nw + d0 + 4);
            bf16_t* O = (type == 2) ? Q : KB; const int cb = (type == 2) ? 2048 : 3072;
            EPI_LOOP(ai, m, bj) { const int tok = row0 + ai * 128 + m * 16, c = col0 + bj * 128 - cb;
                const float tot = ss[ai][m][bj] + xch[(ai * 128 + wr * 64 + m * 16 + fr) * 8 + bj * 4 + (wc ^ 1)];
                const float rstd = __builtin_amdgcn_rsqf(tot * (1.0f / 64.0f) + EPSN);
                f32x4 a = acc[ai][bj][m][0] * rstd * w0, b = acc[ai][bj][m][1] * rstd * w1;
                if (type == 3 && tok < NPROMPT) { *(f32x4*)(ock + (size_t)tok * 1024 + c) = a; *(f32x4*)(ock + (size_t)tok * 1024 + c + 4) = b; }
                a = a * osc; b = b * osc;
                *(u32x4*)(O + (size_t)tok * 1024 + c) = pack8(a, b); }
        }
    }
};

struct EpiS {
    static constexpr bool MIDK = false;
    float* S;
    __device__ __forceinline__ void operator()(const pg8::Acc& acc, const pg8::Unit& u, int wr, int wc, int fr, int fq) const {
        const int row0 = u.pm * 256 + wr * 64 + fr, col0 = wc * 32 + 8 * fq;
        EPI_LOOP(ai, m, bj) { float* p = S + (size_t)(row0 + ai * 128 + m * 16) * 256 + col0 + bj * 128; *(f32x4*)p = acc[ai][bj][m][0]; *(f32x4*)(p + 4) = acc[ai][bj][m][1]; }
    }
};
struct EpiY {
    static constexpr bool MIDK = false;
    bf16_t* YS;
    __device__ __forceinline__ void operator()(const pg8::Acc& acc, const pg8::Unit& u, int wr, int wc, int fr, int fq) const {
        const int g = u.pm >> 1, ch0 = (u.pm & 1) * 256 + wr * 64 + fr, col0 = wc * 32 + 8 * fq;
        EPI_LOOP(ai, m, bj) { const int chunk = ch0 + ai * 128 + m * 16, c = col0 + bj * 128, tau = c >> 4, i0 = c & 15; f32x4 a = acc[ai][bj][m][0], b = acc[ai][bj][m][1];
#pragma unroll
            for (int e = 0; e < 4; ++e) { a[e] = gelu_f(a[e]); b[e] = gelu_f(b[e]); }
            *(u32x4*)(YS + (size_t)(chunk * 16 + tau) * 1024 + g * 16 + i0) = pack8(a, b); }
    }
};
struct EpiGlu {
    static constexpr bool MIDK = false;
    const bf16_t *YS, *ZS; const float* bglu; bf16_t* A2;
    __device__ __forceinline__ void operator()(const pg8::Acc& acc, const pg8::Unit& u, int wr, int wc, int fr, int fq) const {
        const int row0 = u.pm * 256 + wr * 64 + fr, col0 = u.pn * 256 + wc * 32 + 8 * fq;
        EPI_LOOP(ai, m, bj) { const int tok = row0 + ai * 128 + m * 16, c = col0 + bj * 128;
            const f32x4 b0 = *(const f32x4*)(bglu + c), b1 = *(const f32x4*)(bglu + c + 4);
            f32x4 y0, y1, z0, z1; unpack8(*(const u32x4*)(YS + (size_t)tok * 1024 + c), y0, y1); unpack8(*(const u32x4*)(ZS + (size_t)tok * 1024 + c), z0, z1);
            f32x4 a = acc[ai][bj][m][0] + b0, b = acc[ai][bj][m][1] + b1;
#pragma unroll
            for (int e = 0; e < 4; ++e) { a[e] = y0[e] * sigm_f(a[e]) * z0[e]; b[e] = y1[e] * sigm_f(b[e]) * z1[e]; }
            *(u32x4*)(A2 + (size_t)tok * 2048 + c) = pack8(a, b); }
    }
};
struct EpiMerge {
    static constexpr bool MIDK = true;
    const bf16_t *GS, *GA; bf16_t* MG;
    __device__ __forceinline__ void mid(pg8::Acc& acc, const pg8::Unit& u, int wr, int wc, int fr, int fq) const {
        int row0 = u.pm * 256 + wr * 64 + fr, col0 = u.pn * 256 + wc * 32 + 8 * fq;
        asm volatile("" : "+v"(row0), "+v"(col0));
        EPI_LOOP(ai, m, bj) { const size_t off = (size_t)(row0 + ai * 128 + m * 16) * 2048 + col0 + bj * 128;
            f32x4 s0, s1, a0, a1; unpack8(*(const u32x4*)(GS + off), s0, s1); unpack8(*(const u32x4*)(GA + off), a0, a1);
#pragma unroll
            for (int e = 0; e < 4; ++e) { acc[ai][bj][m][0][e] *= s0[e] * __builtin_amdgcn_rcpf(__builtin_fmaxf(a0[e], 1e-30f)); acc[ai][bj][m][1][e] *= s1[e] * __builtin_amdgcn_rcpf(__builtin_fmaxf(a1[e], 1e-30f)); }
            asm volatile("" : "+v"(acc[ai][bj][m][0]), "+v"(acc[ai][bj][m][1]) :: "memory"); }
    }
    __device__ __forceinline__ void operator()(const pg8::Acc& acc, const pg8::Unit& u, int wr, int wc, int fr, int fq) const {
        const int row0 = u.pm * 256 + wr * 64 + fr, col0 = u.pn * 256 + wc * 32 + 8 * fq;
        EPI_LOOP(ai, m, bj) { const size_t off = (size_t)(row0 + ai * 128 + m * 16) * 2048 + col0 + bj * 128;
            f32x4 a0, a1; unpack8(*(const u32x4*)(GA + off), a0, a1);
            *(u32x4*)(MG + off) = pack8(acc[ai][bj][m][0] * a0, acc[ai][bj][m][1] * a1); }
    }
};
struct EpiOut {
    static constexpr bool MIDK = false;
    const float *xp, *xs, *mod; float* out;
    __device__ __forceinline__ void operator()(const pg8::Acc& acc, const pg8::Unit& u, int wr, int wc, int fr, int fq) const {
        const int row0 = u.pm * 256 + wr * 64 + fr, col0 = u.pn * 256 + wc * 32 + 8 * fq;
        const int cond = (u.pm < 16) ? 0 : 1 + ((u.pm - 16) >> 3);
        const float* gate = mod + cond * 6144 + 4096;
        EPI_LOOP(ai, m, bj) { const int tok = row0 + ai * 128 + m * 16, c = col0 + bj * 128;
            const float* xr = (tok < NPROMPT) ? xp + (size_t)tok * 2048 : xs + (size_t)(tok - NPROMPT) * 2048;
            const f32x4 g0 = *(const f32x4*)(gate + c), g1 = *(const f32x4*)(gate + c + 4), x0 = *(const f32x4*)(xr + c), x1 = *(const f32x4*)(xr + c + 4);
            float* o = out + (size_t)tok * 2048 + c; *(f32x4*)o = x0 + g0 * acc[ai][bj][m][0]; *(f32x4*)(o + 4) = x1 + g1 * acc[ai][bj][m][1]; }
    }
};

#define XB_TMO      128
#define XB_XCNT(j)  (256  + 64 * (j))
#define XB_XSUB(j)  (1280 + 64 * (j))
#define XB_XGEN(j)  (2304 + 64 * (j))
#define XB_TOP      3328
#define XB_TOPGEN   3392
#define XCD_BAR_WORDS 3456
#define XB_SPIN_CAP (1u << 20)
__device__ __forceinline__ unsigned xb_ld(unsigned* p)              { return __hip_atomic_load(p, __ATOMIC_RELAXED, __HIP_MEMORY_SCOPE_AGENT); }
__device__ __forceinline__ unsigned xb_add(unsigned* p, unsigned v) { return __hip_atomic_fetch_add(p, v, __ATOMIC_RELAXED, __HIP_MEMORY_SCOPE_AGENT); }
__device__ __forceinline__ unsigned xb_xcc_id() { return (unsigned)__builtin_amdgcn_s_getreg((3 << 11) | 20) & 0xFu; }
#define XB_SPIN(cond, bar) do { unsigned _sp = 0; while (cond) { __builtin_amdgcn_s_sleep(1); \
    if ((++_sp & 255u) == 0u) { if (xb_ld(&(bar)[XB_TMO])) break; if (_sp > XB_SPIN_CAP) { atomicAdd(&(bar)[XB_TMO], 1u); break; } } } } while (0)
struct XcdBarrier { unsigned* bar; unsigned x; volatile LAS unsigned* st; };
__device__ __forceinline__ XcdBarrier xcd_barrier_post(unsigned* bar, volatile LAS unsigned* st) {
    XcdBarrier b; b.bar = bar; b.x = xb_xcc_id(); b.st = st;
    if (threadIdx.x == 0) (void)xb_add(&bar[XB_XCNT(b.x)], 1u);
    return b;
}
__device__ __forceinline__ void xcd_barrier_complete(unsigned* bar, unsigned x, unsigned& nloc, unsigned& nx) {
    const unsigned G = gridDim.x * gridDim.y * gridDim.z;
    unsigned sum, cnt, mine, sp = 0u;
    for (;;) {
        sum = 0u; cnt = 0u; mine = 0u;
#pragma unroll
        for (unsigned j = 0; j < 16; ++j) { const unsigned c = xb_ld(&bar[XB_XCNT(j)]); sum += c; cnt += (c > 0u) ? 1u : 0u; mine = (j == x) ? c : mine; }
        if (sum == G) break;
        __builtin_amdgcn_s_sleep(1);
        if ((++sp & 255u) == 0u) { if (xb_ld(&bar[XB_TMO])) break; if (sp > XB_SPIN_CAP) { atomicAdd(&bar[XB_TMO], 1u); break; } }
    }
    nloc = mine > 0u ? mine : 1u; nx = cnt > 0u ? cnt : 1u;
}
__device__ __forceinline__ void xcd_barrier(const XcdBarrier& b) {
    asm volatile("s_waitcnt vmcnt(0)" ::: "memory");
    __syncthreads();
    if (threadIdx.x == 0) {
        unsigned* bar = b.bar;
        __builtin_amdgcn_s_waitcnt(0);
        unsigned nloc = b.st[0], nx = b.st[1];
        if (nloc == 0u) { xcd_barrier_complete(bar, b.x, nloc, nx); b.st[0] = nloc; b.st[1] = nx; }
        const unsigned old = xb_add(&bar[XB_XSUB(b.x)], 1u);
        const unsigned gen = old / nloc;
        if (old + 1u == (gen + 1u) * nloc) {
            __builtin_amdgcn_fence(__ATOMIC_RELEASE, "agent");
            asm volatile("s_waitcnt vmcnt(0)" ::: "memory");
            const unsigned og = xb_add(&bar[XB_TOP], 1u);
            const unsigned tg = og / nx;
            if (og + 1u == (tg + 1u) * nx) xb_add(&bar[XB_TOPGEN], 1u);
            else XB_SPIN(xb_ld(&bar[XB_TOPGEN]) == tg, bar);
            __builtin_amdgcn_fence(__ATOMIC_ACQUIRE, "agent");
            xb_add(&bar[XB_XGEN(b.x)], 1u);
            asm volatile("s_waitcnt vmcnt(0)" ::: "memory");
        } else {
            XB_SPIN(xb_ld(&bar[XB_XGEN(b.x)]) == gen, bar);
            __builtin_amdgcn_fence(__ATOMIC_ACQUIRE, "agent");
            asm volatile("s_waitcnt vmcnt(0)" ::: "memory");
        }
    }
    __syncthreads();
}

struct Args { const float* in[28]; float* out; unsigned char* ws; int ph_lo, ph_hi; };
typedef const __attribute__((address_space(4))) Args* KP;
__device__ __forceinline__ KP fresh_kp() { KP kp = (KP)__builtin_amdgcn_kernarg_segment_ptr(); asm volatile("" : "+s"(kp)); return kp; }
enum { I_XP = 0, I_XS, I_CK, I_CV, I_SRE, I_SIM, I_C, I_CCTX, I_NORMW, I_WADA, I_BADA, I_WIN, I_QNW, I_KNW, I_RPB, I_ARE, I_AIM, I_LOGDT, I_BRE, I_BIM, I_CRE, I_CIM, I_D, I_WGLU, I_BGLU, I_WSSM, I_WATT, I_WO };

__device__ __forceinline__ void p0_transpose_item(const float* W, int N, bf16_t* WT, int ldt, int koff, LAS float* scr, int item, int lane) {
    const int nblk = N / 64, kb = item / nblk, nb = item % nblk, k0 = 64 * kb, n0 = 64 * nb;
    const int c16 = lane & 15, r4 = lane >> 4;
    f32x4 v[16];
#pragma unroll
    for (int i = 0; i < 16; ++i) v[i] = *(const f32x4*)(W + (size_t)(k0 + 4 * i + r4) * N + n0 + 4 * c16);
#pragma unroll
    for (int i = 0; i < 16; ++i) { LAS float* d = scr + (4 * i + r4) * 65 + 4 * c16; d[0] = v[i][0]; d[1] = v[i][1]; d[2] = v[i][2]; d[3] = v[i][3]; }
    LDS_WAIT(); asm volatile("" ::: "memory");
    const int c = lane & 7;
#pragma unroll
    for (int j = 0; j < 8; ++j) { const int n = (lane >> 3) + 8 * j; const LAS float* sp = scr + (8 * c) * 65 + n;
        u32x4 o; o.x = cvtpk(sp[0 * 65], sp[1 * 65]); o.y = cvtpk(sp[2 * 65], sp[3 * 65]); o.z = cvtpk(sp[4 * 65], sp[5 * 65]); o.w = cvtpk(sp[6 * 65], sp[7 * 65]);
        *(u32x4*)(WT + (size_t)(n0 + n) * ldt + koff + k0 + 8 * c) = o; }
    LDS_WAIT(); asm volatile("" ::: "memory");
}

__device__ __forceinline__ void p0_ssm_prep(KP A, LAS float* sc, int g, int qt, int tid) {
    LAS float* LPr = sc;
    LAS float* LPi = sc + 2176;
    LAS float* BBr = sc + 4352;
    LAS float* BBi = sc + 6400;
    LAS float* CCr = sc + 8448;
    LAS float* CCi = sc + 10496;
    LAS float* KT = sc + 12544;
    LAS float* COr = sc + 14592;
    LAS float* COi = sc + 14720;
    const float* a_re = A->in[I_ARE]; const float* a_im = A->in[I_AIM]; const float* logdt = A->in[I_LOGDT];
    {
        const int d = (tid >> 6) & 1, p = tid & 63, slot = tid >> 7;
        const float are = __builtin_fminf(a_re[(d * 64 + g) * 64 + p], -1e-4f), aim = a_im[(d * 64 + g) * 64 + p];
        const float dt = __expf(logdt[d * 64 + g]);
        const float zr = are * dt, zi = aim * dt;
#pragma unroll 1
        for (int e = slot; e <= 16; e += 4) { float sn, cn; sincos_rad((float)e * zi, sn, cn); const float mg = __expf((float)e * zr); LPr[(d * 17 + e) * 64 + p] = mg * cn; LPi[(d * 17 + e) * 64 + p] = mg * sn; }
        if (slot == 0) {
            float s1, c1, sh, chh; sincos_rad(zi, s1, c1); sincos_rad(0.5f * zi, sh, chh); (void)chh;
            const float em1 = expm1f(zr), mg = em1 + 1.0f;
            const float nr = em1 * c1 - 2.0f * sh * sh, ni = mg * s1;
            const float den = 1.0f / (are * are + aim * aim);
            COr[d * 64 + p] = (nr * are + ni * aim) * den; COi[d * 64 + p] = (ni * are - nr * aim) * den;
        }
    }
    __syncthreads();
    {
        const float* b_re = A->in[I_BRE]; const float* b_im = A->in[I_BIM]; const float* c_re = A->in[I_CRE]; const float* c_im = A->in[I_CIM];
#pragma unroll
        for (int n = 0; n < 4; ++n) { const int idx = tid + 512 * n, d = idx >> 10, p = (idx >> 4) & 63;
            const float br = b_re[((size_t)(d * 64 + g) * 64) * 16 + (idx & 1023)], bi = b_im[((size_t)(d * 64 + g) * 64) * 16 + (idx & 1023)];
            const float cr = COr[d * 64 + p], ci = COi[d * 64 + p];
            BBr[idx] = cr * br - ci * bi; BBi[idx] = cr * bi + ci * br; }
#pragma unroll
        for (int n = 0; n < 4; ++n) { const int idx = tid + 512 * n, d = idx >> 10, i = (idx >> 6) & 15, p = idx & 63;
            CCr[(d * 64 + p) * 16 + i] = c_re[((size_t)(d * 64 + g) * 16 + i) * 64 + p]; CCi[(d * 64 + p) * 16 + i] = c_im[((size_t)(d * 64 + g) * 16 + i) * 64 + p]; }
    }
    __syncthreads();
    {
        const int d = tid >> 8, dloc = (tid >> 6) & 3, i = (tid >> 2) & 15, jq = tid & 3, dl = 4 * qt + dloc;
        f32x4 acc = {0.f, 0.f, 0.f, 0.f};
#pragma unroll 4
        for (int p = 0; p < 64; ++p) {
            const float cr = CCr[(d * 64 + p) * 16 + i], ci = CCi[(d * 64 + p) * 16 + i], lr = LPr[(d * 17 + dl) * 64 + p], li = LPi[(d * 17 + dl) * 64 + p];
            const float tr = cr * lr - ci * li, ti = cr * li + ci * lr;
            const f32x4 br = *(const LAS f32x4*)(BBr + (d * 64 + p) * 16 + 4 * jq), bi = *(const LAS f32x4*)(BBi + (d * 64 + p) * 16 + 4 * jq);
            acc += tr * br - ti * bi;
        }
        *(LAS f32x4*)(KT + (d * 4 + dloc) * 256 + i * 16 + 4 * jq) = acc;
    }
    __syncthreads();
    bf16_t* WA = (bf16_t*)(A->ws + WS_WA) + (size_t)g * 256 * 256;
    bf16_t* WOS = (bf16_t*)(A->ws + WS_WOS) + (size_t)g * 256 * 512;
#pragma unroll 1
    for (int it = 0; it < 4; ++it) {
        const int q = it * 512 + tid, n = 64 * qt + (q >> 5), s = (q >> 1) & 15, jh = q & 1, d = n >> 7, ri = (n >> 6) & 1, p = n & 63;
        const int e = (d == 0) ? 15 - s : s;
        const float lr = LPr[(d * 17 + e) * 64 + p], li = LPi[(d * 17 + e) * 64 + p];
        const f32x4 br0 = *(const LAS f32x4*)(BBr + (d * 64 + p) * 16 + jh * 8), br1 = *(const LAS f32x4*)(BBr + (d * 64 + p) * 16 + jh * 8 + 4);
        const f32x4 bi0 = *(const LAS f32x4*)(BBi + (d * 64 + p) * 16 + jh * 8), bi1 = *(const LAS f32x4*)(BBi + (d * 64 + p) * 16 + jh * 8 + 4);
        const f32x4 v0 = ri == 0 ? lr * br0 - li * bi0 : lr * bi0 + li * br0, v1 = ri == 0 ? lr * br1 - li * bi1 : lr * bi1 + li * br1;
        *(u32x4*)(WA + (size_t)n * 256 + s * 16 + jh * 8) = pack8(v0, v1);
    }
    const float* dsk = A->in[I_D];
#pragma unroll 1
    for (int it = 0; it < 8; ++it) {
        const int q = it * 512 + tid, n = q >> 4, sidx = (q >> 1) & 7, jh = q & 1, tau = n >> 4, i = n & 15;
        int s, dd, dloc;
        if (sidx < 4) { dloc = 3 - sidx; s = tau - 4 * qt - dloc; dd = 0; } else { dloc = sidx - 4; s = tau + 4 * qt + dloc; dd = 1; }
        const bool diag = (qt == 0 && dloc == 0);
        if (s < 0 || s > 15 || (diag && dd == 1)) continue;
        const LAS float* kp = KT + (dd * 4 + dloc) * 256 + i * 16 + jh * 8;
        f32x4 v0 = *(const LAS f32x4*)kp, v1 = *(const LAS f32x4*)(kp + 4);
        if (diag) { const LAS float* k2 = KT + (1 * 4 + 0) * 256 + i * 16 + jh * 8; v0 += *(const LAS f32x4*)k2; v1 += *(const LAS f32x4*)(k2 + 4);
            const float dv = dsk[g * 16 + i]; const int jj = i - jh * 8;
            if (jj >= 0 && jj < 4) v0[jj] += dv; else if (jj >= 4 && jj < 8) v1[jj - 4] += dv; }
        *(u32x4*)(WOS + (size_t)n * 512 + s * 16 + jh * 8) = pack8(v0, v1);
    }
#pragma unroll 1
    for (int it = 0; it < 4; ++it) {
        const int q = it * 512 + tid, n = 64 * qt + (q >> 5), pc = q & 31, tau = n >> 4, i = n & 15;
        const int kk = pc * 8, d = kk >> 7, ri = (kk >> 6) & 1, p0 = kk & 63, f = (d == 0) ? tau + 1 : 16 - tau;
        float v[8];
#pragma unroll
        for (int jj = 0; jj < 8; ++jj) { const int p = p0 + jj; const float cr = CCr[(d * 64 + p) * 16 + i], ci = CCi[(d * 64 + p) * 16 + i], lr = LPr[(d * 17 + f) * 64 + p], li = LPi[(d * 17 + f) * 64 + p];
            v[jj] = ri == 0 ? cr * lr - ci * li : -(cr * li + ci * lr); }
        u32x4 o; o.x = cvtpk(v[0], v[1]); o.y = cvtpk(v[2], v[3]); o.z = cvtpk(v[4], v[5]); o.w = cvtpk(v[6], v[7]);
        *(u32x4*)(WOS + (size_t)n * 512 + 256 + pc * 8) = o;
    }
    __syncthreads();
}

__device__ __forceinline__ void p0_gemv_strip(KP A, LAS float* sc, int s, int tid) {
    LAS float* cs = sc;
    LAS float* red = sc + 6144;
    const float* cctx = A->in[I_CCTX]; const float* c = A->in[I_C];
    for (int i = tid; i < 6144; i += 512) { const float v = (i < 2048) ? cctx[i] : c[i - 2048]; cs[i] = silu_f(v); }
    __syncthreads();
    const int wid = tid >> 6, lane = tid & 63, kk = lane >> 3, c4 = lane & 7;
    const float* W = A->in[I_WADA] + (size_t)(256 * wid + kk) * 6144 + 32 * s + 4 * c4;
    f32x4 a0 = {0.f, 0.f, 0.f, 0.f}, a1 = a0, a2 = a0;
#pragma unroll 32
    for (int it = 0; it < 32; ++it) { const f32x4 w = *(const f32x4*)(W + (size_t)it * 8 * 6144); const int k = 256 * wid + 8 * it + kk;
        a0 += cs[k] * w; a1 += cs[2048 + k] * w; a2 += cs[4096 + k] * w; }
#pragma unroll
    for (int e = 0; e < 4; ++e) {
#pragma unroll
        for (int o = 8; o < 64; o <<= 1) { a0[e] += __shfl_xor(a0[e], o); a1[e] += __shfl_xor(a1[e], o); a2[e] += __shfl_xor(a2[e], o); }
    }
    if (kk == 0) {
#pragma unroll
        for (int e = 0; e < 4; ++e) { red[(wid * 3 + 0) * 32 + c4 * 4 + e] = a0[e]; red[(wid * 3 + 1) * 32 + c4 * 4 + e] = a1[e]; red[(wid * 3 + 2) * 32 + c4 * 4 + e] = a2[e]; }
    }
    __syncthreads();
    if (tid < 96) { const int cnd = tid >> 5, col = tid & 31; float v = A->in[I_BADA][32 * s + col];
#pragma unroll
        for (int w = 0; w < 8; ++w) v += red[(w * 3 + cnd) * 32 + col];
        ((float*)(A->ws + WS_MOD))[cnd * 6144 + 32 * s + col] = v; }
    __syncthreads();
}

constexpr int CW_GEMV = 64;
__device__ __forceinline__ void phase1(KP A, int lane, int wave);
__device__ __forceinline__ void phase0(KP A, LAS unsigned char* lds, int tid, int lane, int wave) {
    const int bx = blockIdx.x, G = gridDim.x;
    unsigned* cnt = (unsigned*)(A->ws + WS_CTL) + CW_GEMV;
#ifndef SUBDUP
#define SUBDUP 0
#endif
    _Pragma("unroll 1") for (int sd_ = 0; sd_ < 1 + (SUBDUP & 1); ++sd_)
    for (int t = bx; t < 256; t += G) {
        if (t < 192) {
            p0_gemv_strip(A, (LAS float*)lds, t, tid);
            VM_WAIT(); __syncthreads();
            if (tid == 0) { __builtin_amdgcn_fence(__ATOMIC_RELEASE, "agent"); VM_WAIT(); __hip_atomic_fetch_add(cnt, 1u, __ATOMIC_RELAXED, __HIP_MEMORY_SCOPE_AGENT); }
        }
        p0_ssm_prep(A, (LAS float*)lds, t >> 2, t & 3, tid);
    }
    LAS float* scr = (LAS float*)(lds + wave * 16640);
    const int gw = bx * NWAVES + wave, NGW = G * NWAVES;
    constexpr int I_IN = 32 * 160, I_GLU = 16 * 16, I_SO = 16 * 32, I_AO = 16 * 32, I_O = 32 * 32, NITEMS = I_IN + I_GLU + I_SO + I_AO + I_O;
    _Pragma("unroll 1") for (int sd_ = 0; sd_ < 1 + ((SUBDUP >> 1) & 1); ++sd_)
    for (int it = gw; it < NITEMS; it += NGW) {
        int r = it;
        if (r < I_IN) { p0_transpose_item(A->in[I_WIN], INW, (bf16_t*)(A->ws + WS_WIN), 2048, 0, scr, r, lane); continue; } r -= I_IN;
        if (r < I_GLU) { p0_transpose_item(A->in[I_WGLU], 1024, (bf16_t*)(A->ws + WS_WGLU), 1024, 0, scr, r, lane); continue; } r -= I_GLU;
        if (r < I_SO) { p0_transpose_item(A->in[I_WSSM], 2048, (bf16_t*)(A->ws + WS_WM), 2048, 0, scr, r, lane); continue; } r -= I_SO;
        if (r < I_AO) { p0_transpose_item(A->in[I_WATT], 2048, (bf16_t*)(A->ws + WS_WM), 2048, 1024, scr, r, lane); continue; } r -= I_AO;
        p0_transpose_item(A->in[I_WO], 2048, (bf16_t*)(A->ws + WS_WO), 2048, 0, scr, r, lane);
    }
    {
        const int gt = bx * 512 + tid, NT = G * 512;
        for (int i = gt; i < 2 * 131072; i += NT) {
            const int which = i >> 17, j = i & 131071;
            const float* src = A->in[which ? I_CV : I_CK] + (size_t)j * 8;
            const f32x4 a = *(const f32x4*)src, b = *(const f32x4*)(src + 4);
            *(u32x4*)((bf16_t*)(A->ws + (which ? WS_CV : WS_CK)) + (size_t)j * 8) = pack8(a, b);
        }
    }
    if (tid == 0) {
        unsigned sp = 0;
        while (__hip_atomic_load(cnt, __ATOMIC_RELAXED, __HIP_MEMORY_SCOPE_AGENT) < 192u) { __builtin_amdgcn_s_sleep(2); if (++sp > (1u << 22)) break; }
        __builtin_amdgcn_fence(__ATOMIC_ACQUIRE, "agent");
        VM_WAIT();
    }
    __syncthreads();
    _Pragma("unroll 1") for (int sd_ = 0; sd_ < 1 + ((SUBDUP >> 3) & 1); ++sd_)
    phase1(A, lane, wave);
}

__device__ __forceinline__ void phase1(KP A, int lane, int wave) {
    const int gw = blockIdx.x * NWAVES + wave, NGW = gridDim.x * NWAVES;
    const float* mod = (const float*)(A->ws + WS_MOD); const float* nw = A->in[I_NORMW];
    bf16_t* XN = (bf16_t*)(A->ws + WS_XN);
    for (int m = gw; m < NTOK; m += NGW) {
        const float* xr = (m < NPROMPT) ? A->in[I_XP] + (size_t)m * 2048 : A->in[I_XS] + (size_t)(m - NPROMPT) * 2048;
        const int cond = (m < NPROMPT) ? 0 : 1 + ((m - NPROMPT) >> 11);
        const float* sh = mod + cond * 6144; const float* scl = sh + 2048;
        f32x4 v[8]; float s = 0.f;
#pragma unroll
        for (int j = 0; j < 8; ++j) { v[j] = *(const f32x4*)(xr + 4 * lane + 256 * j); s += (v[j][0] * v[j][0] + v[j][1] * v[j][1]) + (v[j][2] * v[j][2] + v[j][3] * v[j][3]); }
        const float rstd = __builtin_amdgcn_rsqf(wave_sum(s) * (1.0f / 2048.0f) + EPSN);
#pragma unroll
        for (int j = 0; j < 8; ++j) { const int c = 4 * lane + 256 * j; const f32x4 w = *(const f32x4*)(nw + c), a = *(const f32x4*)(scl + c), b = *(const f32x4*)(sh + c);
            const f32x4 o = (v[j] * rstd * w) * (a + 1.0f) + b; u32x2 pk; pk.x = cvtpk(o[0], o[1]); pk.y = cvtpk(o[2], o[3]);
            *(u32x2*)(XN + (size_t)m * 2048 + c) = pk; }
    }
}

__device__ __forceinline__ void scan_task(KP A, int g, int seq  , int d, int lane) {
    const int p = lane;
    const float are = __builtin_fminf(A->in[I_ARE][(d * 64 + g) * 64 + p], -1e-4f), aim = A->in[I_AIM][(d * 64 + g) * 64 + p];
    const float dt = __expf(A->in[I_LOGDT][d * 64 + g]);
    float ls, lc; sincos_rad(16.0f * aim * dt, ls, lc); const float mg = __expf(16.0f * are * dt);
    const float lr = mg * lc, li = mg * ls;
    const bool smp = seq >= 16;
    const int nC = smp ? 128 : 16, chunk0 = smp ? 256 + 128 * (seq - 16) : 16 * seq;
    float hr = 0.f, hi = 0.f;
    if (smp) { const int sb = seq - 16; hr = A->in[I_SRE][((sb * 2 + d) * 64 + g) * 64 + p]; hi = A->in[I_SIM][((sb * 2 + d) * 64 + g) * 64 + p]; }
    const float* S = (const float*)(A->ws + WS_S) + (size_t)(g * 512 + chunk0) * 256 + d * 128 + p;
    bf16_t* H = (bf16_t*)(A->ws + WS_UH) + (size_t)(g * 512 + chunk0) * 512 + 256 + d * 128 + p;
    for (int i0 = 0; i0 < nC; i0 += 8) {
        float sr[8], si[8];
#pragma unroll
        for (int k = 0; k < 8; ++k) { const int c = (d == 0) ? i0 + k : nC - 1 - (i0 + k); sr[k] = S[(size_t)c * 256]; si[k] = S[(size_t)c * 256 + 64]; }
#pragma unroll
        for (int k = 0; k < 8; ++k) { const int c = (d == 0) ? i0 + k : nC - 1 - (i0 + k);
            H[(size_t)c * 512] = (bf16_t)(cvtpk(hr, 0.f) & 0xffffu); H[(size_t)c * 512 + 64] = (bf16_t)(cvtpk(hi, 0.f) & 0xffffu);
            const float nr = lr * hr - li * hi + sr[k], ni = lr * hi + li * hr + si[k]; hr = nr; hi = ni; }
    }
    if (!smp) { A->out[OUT_SRE + ((size_t)(seq * 2 + d) * 64 + g) * 64 + p] = hr; A->out[OUT_SIM + ((size_t)(seq * 2 + d) * 64 + g) * 64 + p] = hi; }
}
__device__ __forceinline__ void phase4(KP A, int lane, int wave) {
    const int gw = blockIdx.x * NWAVES + wave, NGW = gridDim.x * NWAVES;
    for (int t = gw; t < 2304; t += NGW) {
        if (t < 256) scan_task(A, t >> 2, 16 + ((t >> 1) & 1), t & 1, lane);
        else { const int q = t - 256; scan_task(A, q >> 5, (q >> 1) & 15, q & 1, lane); }
    }
}

namespace att {
constexpr int KB0 = 0, VB0 = 16384, WSF = 32768, STG = 34816, BIAS = 67584;
__device__ __forceinline__ int crow(int r, int hi) { return (r & 3) + 8 * (r >> 2) + 4 * hi; }
__device__ __forceinline__ s16x4 vtr(const LAS unsigned char* p) { return __builtin_bit_cast(s16x4, __builtin_amdgcn_ds_read_tr16_b64_v4i16((LAS s16x4*)p)); }

template <bool NA>
__device__ __forceinline__ void unit(KP A, LAS unsigned char* lds, int un, int tid) {
    const int lane = tid & 63, r32 = lane & 31, hi = lane >> 5, wid = __builtin_amdgcn_readfirstlane(tid >> 6);
    const bf16_t* Q = (const bf16_t*)(A->ws + WS_Q); const bf16_t* KBp = (const bf16_t*)(A->ws + WS_KB); const bf16_t* VBp = (const bf16_t*)(A->ws + WS_VB);
    const bf16_t* CK = (const bf16_t*)(A->ws + WS_CK); const bf16_t* CV = (const bf16_t*)(A->ws + WS_CV);
    const bf16_t* ZA = (const bf16_t*)(A->ws + WS_ZA); bf16_t* A2 = (bf16_t*)(A->ws + WS_A2);
    int b, h, NT, qtok0, r = 0, rs = 0, rlo = 0, half = 0;
    if (NA) { b = un >> 7; h = (un >> 3) & 15; const int R4 = un & 7; r = 4 * R4 + (wid >> 1); half = wid & 1; qtok0 = NPROMPT + b * 2048 + r * 64 + half * 32;
        rs = min(max(r - 4, 0), 24); rlo = min(max(4 * R4 - 4, 0), 24); const int rhi = min(max(4 * R4 - 1, 0), 24) + 7; NT = 8 + (rhi - rlo + 1); }
    else { b = un >> 4; h = un & 15; qtok0 = b * 256 + wid * 32; NT = 4; }
    LAS float* wsf = (LAS float*)(lds + WSF) + wid * 64;
    LAS float* bl = (LAS float*)(lds + BIAS);
    if (NA) { if (tid < 465) bl[tid] = A->in[I_RPB][h * 465 + tid] * LOG2E; }
    bf16x8 qr[4];
    { const bf16_t* qp = Q + (size_t)(qtok0 + r32) * 1024 + h * 64 + hi * 8;
#pragma unroll
      for (int d0 = 0; d0 < 4; ++d0) qr[d0] = *(const bf16x8*)(qp + d0 * 16); }
    const int krow = lane, kcol = wid * 8, vrow = 16 * (wid & 3) + (lane >> 2), vcol = (wid >> 2) * 32 + (lane & 3) * 8;
    auto tile_rows = [&](int t, const bf16_t*& kb, const bf16_t*& vb) {
        if (NA) { if (t < 8) { const size_t o = (size_t)(b * 512 + 64 * t) * 1024 + h * 64; kb = CK + o; vb = CV + o; }
                  else { const size_t o = (size_t)(NPROMPT + b * 2048 + (rlo + t - 8) * 64) * 1024 + h * 64; kb = KBp + o; vb = VBp + o; } }
        else { const size_t o = (size_t)(b * 256 + 64 * t) * 1024 + h * 64; kb = KBp + o; vb = VBp + o; }
    };
    u32x4 kreg, vreg;
    { const bf16_t *kb, *vb; tile_rows(0, kb, vb); kreg = *(const u32x4*)(kb + (size_t)krow * 1024 + kcol); vreg = *(const u32x4*)(vb + (size_t)vrow * 1024 + vcol); }
    float mrun = -1e30f, lrun = 0.f; f32x16 o0 = {}, o1 = {};
    const int qc = half * 32 + r32, cs = min(max(qc - 8, 0), 48);
#pragma unroll 1
    for (int t = 0; t < NT; ++t) {
        const int buf = t & 1;
        *(LAS u32x4*)(lds + KB0 + buf * 8192 + wid * 1024 + lane * 16) = kreg;
        *(LAS u32x4*)(lds + VB0 + buf * 8192 + wid * 1024 + lane * 16) = vreg;
        __syncthreads();
        if (t + 1 < NT) { const bf16_t *kb, *vb; tile_rows(t + 1, kb, vb); kreg = *(const u32x4*)(kb + (size_t)krow * 1024 + kcol); vreg = *(const u32x4*)(vb + (size_t)vrow * 1024 + vcol); }
        const int kr = rlo + t - 8;
        const bool active = !NA || t < 8 || (kr >= rs && kr < rs + 8);
        if (active) {
            f32x16 p0 = {}, p1 = {};
            { const LAS unsigned char* kb = lds + KB0 + buf * 8192 + hi * 1024 + r32 * 16;
#pragma unroll
              for (int d0 = 0; d0 < 4; ++d0) { const bf16x8 b0 = *(const LAS bf16x8*)(kb + d0 * 2048), b1 = *(const LAS bf16x8*)(kb + d0 * 2048 + 512);
                  p0 = __builtin_amdgcn_mfma_f32_32x32x16_bf16(b0, qr[d0], p0, 0, 0, 0); p1 = __builtin_amdgcn_mfma_f32_32x32x16_bf16(b1, qr[d0], p1, 0, 0, 0); } }
            if (NA && t >= 8) {
                const int dr = kr - r + 7; const LAS float* brow = bl + dr * 31 + 15 - qc;
#pragma unroll
                for (int rr = 0; rr < 16; ++rr) { const int kc = crow(rr, hi);
                    { const bool ok = (kc >= cs) && (kc < cs + 16); const int ix = min(max(kc - qc + 15, 0), 30); (void)brow; const float bv = bl[dr * 31 + ix]; p0[rr] = ok ? p0[rr] + bv : -1e30f; }
                    { const int kc2 = kc + 32; const bool ok = (kc2 >= cs) && (kc2 < cs + 16); const int ix = min(max(kc2 - qc + 15, 0), 30); const float bv = bl[dr * 31 + ix]; p1[rr] = ok ? p1[rr] + bv : -1e30f; } }
            }
            float mt = p0[0];
#pragma unroll
            for (int rr = 1; rr < 16; ++rr) mt = __builtin_fmaxf(mt, p0[rr]);
#pragma unroll
            for (int rr = 0; rr < 16; ++rr) mt = __builtin_fmaxf(mt, p1[rr]);
            mt = __builtin_fmaxf(mt, __shfl_xor(mt, 32));
            const float mnew = __builtin_fmaxf(mrun, mt);
            if (__any(mnew > mrun)) {
                const float alpha = __builtin_amdgcn_exp2f(mrun - mnew);
                lrun *= alpha; mrun = mnew;
                if (hi == 0) wsf[r32] = alpha;
                LDS_WAIT();
#pragma unroll
                for (int rr = 0; rr < 16; ++rr) { const float f = wsf[crow(rr, hi)]; o0[rr] *= f; o1[rr] *= f; }
            }
            float sacc = 0.f;
#pragma unroll
            for (int rr = 0; rr < 16; ++rr) { p0[rr] = __builtin_amdgcn_exp2f(p0[rr] - mrun); p1[rr] = __builtin_amdgcn_exp2f(p1[rr] - mrun); sacc += p0[rr] + p1[rr]; }
            lrun += sacc;
            u32x4 pw[4];
            pw[0] = (u32x4){cvtpk(p0[0], p0[1]), cvtpk(p0[2], p0[3]), cvtpk(p0[4], p0[5]), cvtpk(p0[6], p0[7])};
            pw[1] = (u32x4){cvtpk(p0[8], p0[9]), cvtpk(p0[10], p0[11]), cvtpk(p0[12], p0[13]), cvtpk(p0[14], p0[15])};
            pw[2] = (u32x4){cvtpk(p1[0], p1[1]), cvtpk(p1[2], p1[3]), cvtpk(p1[4], p1[5]), cvtpk(p1[6], p1[7])};
            pw[3] = (u32x4){cvtpk(p1[8], p1[9]), cvtpk(p1[10], p1[11]), cvtpk(p1[12], p1[13]), cvtpk(p1[14], p1[15])};
            const LAS unsigned char* vp = lds + VB0 + buf * 8192 + ((lane >> 4) & 1) * 32 + (lane & 3) * 8 + (4 * hi + ((lane & 15) >> 2)) * 64;
#pragma unroll
            for (int k = 0; k < 4; ++k) {
                const s16x4 l0 = vtr(vp + k * 1024), h0 = vtr(vp + k * 1024 + 512), l1 = vtr(vp + 4096 + k * 1024), h1 = vtr(vp + 4096 + k * 1024 + 512);
                const bf16x8 v0 = (bf16x8){l0[0], l0[1], l0[2], l0[3], h0[0], h0[1], h0[2], h0[3]}, v1 = (bf16x8){l1[0], l1[1], l1[2], l1[3], h1[0], h1[1], h1[2], h1[3]};
                const bf16x8 pa = __builtin_bit_cast(bf16x8, pw[k]);
                o0 = __builtin_amdgcn_mfma_f32_32x32x16_bf16(pa, v0, o0, 0, 0, 0); o1 = __builtin_amdgcn_mfma_f32_32x32x16_bf16(pa, v1, o1, 0, 0, 0);
            }
        }
    }
    const float ltot = lrun + __shfl_xor(lrun, 32);
    if (hi == 0) wsf[32 + r32] = ltot;
    LDS_WAIT();
    LAS bf16_t* stg = (LAS bf16_t*)(lds + STG) + wid * 2048;
#pragma unroll
    for (int rr = 0; rr < 16; ++rr) { const int orow = crow(rr, hi); const float rl = __builtin_amdgcn_rcpf(wsf[32 + orow]);
        stg[orow * 64 + r32] = (bf16_t)(cvtpk(o0[rr] * rl, 0.f) & 0xffffu); stg[orow * 64 + 32 + r32] = (bf16_t)(cvtpk(o1[rr] * rl, 0.f) & 0xffffu); }
    LDS_WAIT();
#pragma unroll
    for (int i = 0; i < 4; ++i) { const int row = i * 8 + (lane >> 3), ch = lane & 7; const u32x4 ov = *(const LAS u32x4*)(stg + row * 64 + ch * 8);
        const size_t tok = (size_t)(qtok0 + row);
        f32x4 a0, a1, z0, z1; unpack8(ov, a0, a1); unpack8(*(const u32x4*)(ZA + tok * 1024 + h * 64 + ch * 8), z0, z1);
        *(u32x4*)(A2 + tok * 2048 + 1024 + h * 64 + ch * 8) = pack8(a0 * z0, a1 * z1); }
    __syncthreads();
}
}

constexpr int NPHASE = 9;
__device__ __forceinline__ int opaque_i(int v) { asm volatile("" : "+s"(v)); return v; }
__global__ void __launch_bounds__(NWAVES * 64, 2) fwd_kernel(Args args_unused) {
    KP args = fresh_kp();
    extern __shared__ __attribute__((aligned(16))) unsigned char lds_raw[];
    LAS unsigned char* lds = (LAS unsigned char*)lds_raw;
    volatile LAS unsigned* MISC = (volatile LAS unsigned*)(lds + MISC_OFF);
    const int tid = threadIdx.x, lane = tid & 63, wave = __builtin_amdgcn_readfirstlane(tid >> 6);
    const int G = gridDim.x;
    for (int u = tid; u < (LDS_BYTES - MISC_OFF) / 4; u += NWAVES * 64) ((LAS unsigned*)(lds + MISC_OFF))[u] = 0u;
    __syncthreads();
    unsigned* barw = (unsigned*)(args->ws + WS_CTL) + 4096;
    const int lo = args->ph_lo, hi = args->ph_hi;
    const bool one = (hi - lo) > 1;
    XcdBarrier bar; bar.bar = barw; bar.x = 0; bar.st = nullptr;
    if (one) bar = xcd_barrier_post(barw, MISC + 8);
#ifndef PHMASK
#define PHMASK 0x1ff
#endif
#define IN(k) (((PHMASK >> (k)) & 1) && lo <= (k) && (k) < hi)
#ifndef DUPMASK
#define DUPMASK 0
#endif
#define REP(k) _Pragma("unroll 1") for (int rep_ = 0; rep_ < 1 + ((DUPMASK >> (k)) & 1); ++rep_)
#define NREP(k) (1 + ((DUPMASK >> (k)) & 1))
#define SEAM(k) do { if (IN(k) && IN((k) + 1)) xcd_barrier(bar); } while (0)

    if (IN(0)) { KP kp = fresh_kp(); REP(0) phase0(kp, lds, tid, lane, wave); if (IN(2)) xcd_barrier(bar); }
    if (IN(2)) {
        KP kp = fresh_kp(); unsigned char* ws = kp->ws;
        pg8::Gemm g{(const bf16_t*)(ws + WS_XN), (const bf16_t*)(ws + WS_WIN), 2048, 2048, 2048};
        pg8::StaticOrder S; S.init(32, 40, G, (int)blockIdx.x, NREP(2));
        EpiIn E{(bf16_t*)(ws + WS_UH), (bf16_t*)(ws + WS_ZS), (bf16_t*)(ws + WS_Q), (bf16_t*)(ws + WS_KB), (bf16_t*)(ws + WS_VB), (bf16_t*)(ws + WS_ZA), (bf16_t*)(ws + WS_GS), (bf16_t*)(ws + WS_GA),
                kp->out + OUT_CK, kp->out + OUT_CV, kp->in[I_QNW], kp->in[I_KNW], (LAS float*)(lds + XCH_OFF)};
        pg8::gemm_phase<EpiIn, pg8::StaticOrder, true>(lds, g, S, E);
        SEAM(2);
    }
    if (IN(3)) { {
        {
            KP kp = fresh_kp(); unsigned char* ws = kp->ws;
            pg8::Gemm g{(const bf16_t*)(ws + WS_UH), (const bf16_t*)(ws + WS_WA), 512, 256, 256};
            pg8::SsmOrder S{G, (int)blockIdx.x, NREP(3)};
            EpiS E{(float*)(ws + WS_S)};
            pg8::gemm_phase<EpiS, pg8::SsmOrder, false>(lds, g, S, E);
        }
        for (int un = blockIdx.x; un < 256 * NREP(3); un += G) { KP kp = fresh_kp(); att::unit<true>(kp, lds, un & 255, tid); }
        for (int un = blockIdx.x; un < 256 * NREP(3); un += G) { KP kp = fresh_kp(); att::unit<false>(kp, lds, un & 255, tid); }
        }
        SEAM(3);
    }
    if (IN(4)) { KP kp = fresh_kp(); REP(4) phase4(kp, lane, wave); SEAM(4); }
    if (IN(5)) {
        KP kp = fresh_kp(); unsigned char* ws = kp->ws;
        pg8::Gemm g{(const bf16_t*)(ws + WS_UH), (const bf16_t*)(ws + WS_WOS), 512, 512, 512};
        pg8::SsmOrder S{G, (int)blockIdx.x, NREP(5)};
        EpiY E{(bf16_t*)(ws + WS_YS)};
        pg8::gemm_phase<EpiY, pg8::SsmOrder, false>(lds, g, S, E);
        SEAM(5);
    }
    if (IN(6)) {
        KP kp = fresh_kp(); unsigned char* ws = kp->ws;
        pg8::Gemm g{(const bf16_t*)(ws + WS_YS), (const bf16_t*)(ws + WS_WGLU), 1024, 1024, 1024};
        pg8::StaticOrder S; S.init(32, 4, G, (int)blockIdx.x, NREP(6));
        EpiGlu E{(const bf16_t*)(ws + WS_YS), (const bf16_t*)(ws + WS_ZS), kp->in[I_BGLU], (bf16_t*)(ws + WS_A2)};
        pg8::gemm_phase<EpiGlu, pg8::StaticOrder, false>(lds, g, S, E);
        SEAM(6);
    }
    if (IN(7)) {
        KP kp = fresh_kp(); unsigned char* ws = kp->ws;
        pg8::Gemm g{(const bf16_t*)(ws + WS_A2), (const bf16_t*)(ws + WS_WM), 2048, 2048, 2048};
        pg8::StaticOrder S; S.init(32, 8, G, (int)blockIdx.x, NREP(7));
        EpiMerge E{(const bf16_t*)(ws + WS_GS), (const bf16_t*)(ws + WS_GA), (bf16_t*)(ws + WS_MG)};
        pg8::gemm_phase<EpiMerge, pg8::StaticOrder, false>(lds, g, S, E);
        SEAM(7);
    }
    if (IN(8)) {
        KP kp = fresh_kp(); unsigned char* ws = kp->ws;
        pg8::Gemm g{(const bf16_t*)(ws + WS_MG), (const bf16_t*)(ws + WS_WO), 2048, 2048, 2048};
        pg8::StaticOrder S; S.init(32, 8, G, (int)blockIdx.x, NREP(8));
        EpiOut E{kp->in[I_XP], kp->in[I_XS], (const float*)(ws + WS_MOD), kp->out + OUT_Y};
        pg8::gemm_phase<EpiOut, pg8::StaticOrder, false>(lds, g, S, E);
    }
#undef IN
#undef SEAM
}

extern "C" void kernel_launch(void* const* d_in, const int* in_sizes, int n_in, void* d_out, int out_size, void* d_ws, size_t ws_size, hipStream_t stream) {
    static int grid = 0;
    if (grid == 0) {
        if (n_in != 28 || out_size != (int)OUT_TOTAL || ws_size < WS_END) { fprintf(stderr, "kernel_launch: unexpected problem (n_in %d, out %d, ws %zu)\n", n_in, out_size, ws_size); grid = -1; return; }
        int dev = 0, cus = 0, per_cu = 0;
        if (hipGetDevice(&dev) != hipSuccess || hipDeviceGetAttribute(&cus, hipDeviceAttributeMultiprocessorCount, dev) != hipSuccess) { grid = -1; return; }
        if (hipFuncSetAttribute((const void*)fwd_kernel, hipFuncAttributeMaxDynamicSharedMemorySize, LDS_BYTES) != hipSuccess) { fprintf(stderr, "kernel_launch: hipFuncSetAttribute failed\n"); grid = -1; return; }
        if (hipOccupancyMaxActiveBlocksPerMultiprocessor(&per_cu, (const void*)fwd_kernel, NWAVES * 64, LDS_BYTES) != hipSuccess || per_cu < 1) { fprintf(stderr, "kernel_launch: occupancy query says %d\n", per_cu); per_cu = 1; }
        (void)hipGetLastError();
        grid = cus;
        fprintf(stderr, "kernel_launch: grid %d (cus %d, per_cu %d), ws %zu\n", grid, cus, per_cu, ws_size);
    }
    if (grid < 0) return;
    (void)hipMemsetAsync((char*)d_ws + WS_CTL, 0, CTL_ZERO_BYTES, stream);
    Args a{};
    for (int i = 0; i < 28; ++i) a.in[i] = (const float*)d_in[i];
    a.out = (float*)d_out; a.ws = (unsigned char*)d_ws;
#if MK_N_LAUNCHES == 1
    a.ph_lo = 0; a.ph_hi = NPHASE;
    void* params[] = {&a};
    hipError_t e = hipLaunchCooperativeKernel((const void*)fwd_kernel, dim3(grid), dim3(NWAVES * 64), params, LDS_BYTES, stream);
    if (e != hipSuccess) fprintf(stderr, "kernel_launch: cooperative launch failed: %s\n", hipGetErrorString(e));
#else
    for (int p = 0; p < NPHASE; ++p) {
        a.ph_lo = p; a.ph_hi = p + 1;
        hipLaunchKernelGGL(fwd_kernel, dim3(grid), dim3(NWAVES * 64), LDS_BYTES, stream, a);
    }
#endif
}
```

```cpp
#include <hip/hip_runtime.h>
#include <cstdio>
#include <cstdint>

#ifndef MK_N_LAUNCHES
#define MK_N_LAUNCHES 1
#endif

#define GAS __attribute__((address_space(1)))
#define LAS __attribute__((address_space(3)))
typedef unsigned short bf16_t;
typedef short bf16x8 __attribute__((ext_vector_type(8)));
typedef short s16x4 __attribute__((ext_vector_type(4)));
typedef float f32x4 __attribute__((ext_vector_type(4)));
typedef float f32x16 __attribute__((ext_vector_type(16)));
typedef unsigned u32x4 __attribute__((ext_vector_type(4)));
typedef unsigned u32x2 __attribute__((ext_vector_type(2)));
typedef float f32x2_t __attribute__((ext_vector_type(2)));
typedef __bf16 bf16x2_t __attribute__((ext_vector_type(2)));

constexpr int DM = 2048, NTOK = 8192, NPROMPT = 4096, INW = 10240, SSMW = 1024, ATTW = 1024, NH = 16, HD = 64;
constexpr int NGRP = 64, NSTATE = 64, TCH = 16;
constexpr float EPSN = 1e-6f;
constexpr float LOG2E = 1.4426950408889634f;
constexpr float QSCALE = 0.125f * LOG2E;

constexpr size_t MiB = 1u << 20;
constexpr size_t WS_CTL = 0, CTL_ZERO_BYTES = 32768;
constexpr size_t WS_MOD = 1 * MiB;
constexpr size_t WS_WIN = 2 * MiB;
constexpr size_t WS_A2 = 2 * MiB;
constexpr size_t WS_WGLU = 42 * MiB;
constexpr size_t WS_WM = 44 * MiB;
constexpr size_t WS_WO = 52 * MiB;
constexpr size_t WS_WA = 60 * MiB;
constexpr size_t WS_WOS = 68 * MiB;
constexpr size_t WS_CK = 84 * MiB, WS_CV = 86 * MiB;
constexpr size_t WS_XN = 88 * MiB;
constexpr size_t WS_S = 88 * MiB;
constexpr size_t WS_UH = 120 * MiB;
constexpr size_t WS_MG = 120 * MiB;
constexpr size_t WS_ZS = 152 * MiB;
constexpr size_t WS_Q = 168 * MiB;
constexpr size_t WS_YS = 296 * MiB;
constexpr size_t WS_KB = 184 * MiB, WS_VB = 200 * MiB, WS_ZA = 216 * MiB;
constexpr size_t WS_GS = 232 * MiB, WS_GA = 264 * MiB;
constexpr size_t WS_END = 312 * MiB;

constexpr size_t OUT_Y = 0, OUT_CK = 16777216, OUT_CV = 20971520, OUT_SRE = 25165824, OUT_SIM = 25296896, OUT_TOTAL = 25427968;

constexpr int RING_BYTES = 131072;
constexpr int XCH_OFF = RING_BYTES;
constexpr int MISC_OFF = RING_BYTES + 8192;
constexpr int LDS_BYTES = 147456;

constexpr int NWAVES = 8;

__device__ __forceinline__ unsigned cvtpk(float lo, float hi) { f32x2_t v = {lo, hi}; bf16x2_t b = __builtin_convertvector(v, bf16x2_t); return __builtin_bit_cast(unsigned, b); }
__device__ __forceinline__ float bf2f(unsigned short h) { return __builtin_bit_cast(float, (unsigned)h << 16); }
__device__ __forceinline__ float bflo(unsigned w) { return __builtin_bit_cast(float, w << 16); }
__device__ __forceinline__ float bfhi(unsigned w) { return __builtin_bit_cast(float, w & 0xffff0000u); }
__device__ __forceinline__ float sigm_f(float x) { return __builtin_amdgcn_rcpf(1.f + __builtin_amdgcn_exp2f(-LOG2E * x)); }
__device__ __forceinline__ float silu_f(float x) { return x * sigm_f(x); }
__device__ __forceinline__ float gelu_f(float x) { return x * sigm_f(1.5957691216057308f * (x + 0.044715f * x * x * x)); }
__device__ __forceinline__ u32x4 pack8(f32x4 a, f32x4 b) { u32x4 w; w.x = cvtpk(a[0], a[1]); w.y = cvtpk(a[2], a[3]); w.z = cvtpk(b[0], b[1]); w.w = cvtpk(b[2], b[3]); return w; }
__device__ __forceinline__ void unpack8(u32x4 w, f32x4& a, f32x4& b) { a = (f32x4){bflo(w.x), bfhi(w.x), bflo(w.y), bfhi(w.y)}; b = (f32x4){bflo(w.z), bfhi(w.z), bflo(w.w), bfhi(w.w)}; }
__device__ __forceinline__ float wave_sum(float v) {
#pragma unroll
    for (int o = 1; o < 64; o <<= 1) v += __shfl_xor(v, o);
    return v;
}
__device__ __forceinline__ void sincos_rad(float x, float& s, float& c) {
    float rev = x * 0.15915494309189535f; rev -= __builtin_floorf(rev);
    s = __builtin_amdgcn_sinf(rev); c = __builtin_amdgcn_cosf(rev);
}
#define LDS_WAIT() asm volatile("s_waitcnt lgkmcnt(0)" ::: "memory")
#define VM_WAIT() asm volatile("s_waitcnt vmcnt(0)" ::: "memory")

namespace pg8 {
constexpr int BM = 256, BK = 64, HALF = 128, HTB = HALF * BK * 2, STAGE_BYTES = 8 * HTB, NXCD = 8, WGM = 8;
__host__ __device__ __forceinline__ int lds_byte(int r, int c) { const int st = (r >> 4) * 2 + (c >> 5), rr = r & 15, cc = c & 31, ob = rr * 64 + cc * 2; return st * 1024 + (ob ^ (((ob >> 9) & 1) << 5)); }
__host__ __device__ __forceinline__ void stage_rc(int b, int& R, int& C) { const int st = b / 1024, sb = b % 1024, swz = sb ^ (((sb >> 9) & 1) << 5); R = (st >> 1) * 16 + swz / 64; C = (st & 1) * 32 + (swz % 64) / 2; }
__host__ __device__ __forceinline__ int perm32(int rho) { const int n = rho >> 4, i = rho & 15; return 8 * (i >> 2) + 4 * n + (i & 3); }

struct Unit { int pm, pn; };
struct Gemm { const bf16_t* A; const bf16_t* Bt; int lda, ldb, K; };

struct StaticOrder {
    int nM, nN, nwg, G, c, rep;
    __device__ void init(int nM_, int nN_, int G_, int c_, int rep_ = 1) { nM = nM_; nN = nN_; nwg = nM * nN; G = G_; c = c_; rep = rep_; }
    __device__ bool next(int i, Unit& u) const {
        long L = (long)i * G + c; if (L >= (long)nwg * rep) return false; if (L >= nwg) L -= nwg;
        int wgid = (int)L; { const int q = nwg / NXCD, r = nwg % NXCD, xcd = wgid % NXCD, off = wgid / NXCD; wgid = (xcd < r ? xcd * (q + 1) : r * (q + 1) + (xcd - r) * q) + off; }
        const int nig = WGM * nN, gid = wgid / nig, fm = gid * WGM, gsz = (nM - fm) < WGM ? (nM - fm) : WGM;
        u.pm = fm + ((wgid % nig) % gsz); u.pn = (wgid % nig) / gsz; return true;
    }
};
struct OneUnit { int pm, pn; __device__ bool next(int i, Unit& u) const { if (i) return false; u.pm = pm; u.pn = pn; return true; } };
struct SsmOrder {
    int G, c, rep;
    __device__ bool next(int i, Unit& u) const { int L = i * G + c; if (L >= 128 * rep) return false; L &= 127; u.pm = L; u.pn = L >> 1; return true; }
};

typedef f32x4 Acc[2][2][4][2];

template <class Epi, class Sched, bool ALIGN_EPI>
__device__ __forceinline__ void gemm_phase(LAS unsigned char* lds, const Gemm g, const Sched& S, const Epi& E) {
    int tid = threadIdx.x; asm volatile("" : "+v"(tid));
    const int wid = __builtin_amdgcn_readfirstlane(tid >> 6), lane = tid & 63, wr = wid >> 2, wc = wid & 3, fr = lane & 15, fq = lane >> 4;
    const int K = g.K, nt = K / BK;
    unsigned voffA[2], voffB[2];
#pragma unroll
    for (int i = 0; i < 2; ++i) { int R, C; stage_rc(tid * 16 + i * 8192, R, C); const int Rb = (R & ~31) + perm32(R & 31);
        voffA[i] = (unsigned)(R * g.lda + C) * 2u; voffB[i] = (unsigned)(Rb * g.ldb + C) * 2u; }
    const size_t kstep = (size_t)(BK * 2);
    const size_t hA = (size_t)HALF * g.lda * 2, hB = (size_t)HALF * g.ldb * 2, tA = 2 * hA, tB = 2 * hB;
    const unsigned ldsw = (unsigned)wid * 1024u;
    const int aoff = lds_byte(wr * 64 + fr, fq * 8), boff = lds_byte(wc * 32 + fr, fq * 8);
#define PG8_SA(b, h) (((b) * 2 + (h)) * HTB)
#define PG8_SB(b, h) ((4 + (b) * 2 + (h)) * HTB)
#define PG8_STAGE(bufoff, gbase, voff) do { _Pragma("unroll") for (int _i = 0; _i < 2; ++_i) \
        __builtin_amdgcn_global_load_lds((const unsigned*)((const char*)(gbase) + (voff)[_i]), (LAS unsigned*)(lds + (bufoff) + ldsw + _i * 8192), 16, 0, 0); } while (0)
#define PG8_LDA(dst, b, h) do { _Pragma("unroll") for (int m = 0; m < 4; ++m) _Pragma("unroll") for (int k = 0; k < 2; ++k) dst[m][k] = *(const LAS bf16x8*)(lds + PG8_SA(b, h) + aoff + m * 2048 + k * 1024); } while (0)
#define PG8_LDB(dst, b, h) do { _Pragma("unroll") for (int n = 0; n < 2; ++n) _Pragma("unroll") for (int k = 0; k < 2; ++k) dst[n][k] = *(const LAS bf16x8*)(lds + PG8_SB(b, h) + boff + n * 2048 + k * 1024); } while (0)
#define PG8_MMA(ai, bj, At, Bt) do { __builtin_amdgcn_s_setprio(1); _Pragma("unroll") for (int m = 0; m < 4; ++m) _Pragma("unroll") for (int n = 0; n < 2; ++n) _Pragma("unroll") for (int k = 0; k < 2; ++k) \
        acc[ai][bj][m][n] = __builtin_amdgcn_mfma_f32_16x16x32_bf16(Bt[n][k], At[m][k], acc[ai][bj][m][n], 0, 0, 0); __builtin_amdgcn_s_setprio(0); } while (0)
#define PG8_WAIT_V(n) asm volatile("s_waitcnt vmcnt(" #n ")" ::: "memory")
#define PG8_WAIT_L(n) asm volatile("s_waitcnt lgkmcnt(" #n ")" ::: "memory")
#define PG8_BAR __builtin_amdgcn_s_barrier()
#define PG8_SCHED __builtin_amdgcn_sched_barrier(0)
    Unit cur, nxt; int ui = 0;
    if (!S.next(0, cur)) return;
    Acc acc;
#pragma unroll
    for (int a = 0; a < 2; ++a)
#pragma unroll
        for (int b = 0; b < 2; ++b)
#pragma unroll
            for (int m = 0; m < 4; ++m)
#pragma unroll
                for (int n = 0; n < 2; ++n) acc[a][b][m][n] = (f32x4){0.f, 0.f, 0.f, 0.f};
    bf16x8 At[4][2], B0[2][2], B1[2][2];
    const char* cA = (const char*)g.A + (size_t)cur.pm * tA; const char* cB = (const char*)g.Bt + (size_t)cur.pn * tB;
    PG8_STAGE(PG8_SB(0, 0), cB, voffB); PG8_STAGE(PG8_SB(0, 1), cB + hB, voffB); PG8_STAGE(PG8_SA(0, 0), cA, voffA); PG8_STAGE(PG8_SA(0, 1), cA + hA, voffA);
    if (wr == 1) PG8_BAR;
    PG8_WAIT_V(2); PG8_BAR;
    PG8_STAGE(PG8_SB(1, 0), cB + kstep, voffB); PG8_STAGE(PG8_SA(1, 0), cA + kstep, voffA); PG8_STAGE(PG8_SB(1, 1), cB + hB + kstep, voffB);
    PG8_WAIT_V(6); PG8_BAR;
    for (;;) {
        const bool has_next = S.next(ui + 1, nxt);
        const char* nA = has_next ? (const char*)g.A + (size_t)nxt.pm * tA : cA; const char* nB = has_next ? (const char*)g.Bt + (size_t)nxt.pn * tB : cB;
#pragma unroll 1
        for (int t = 0; t < nt; t += 2) {
            const bool last = (t == nt - 2);
            const char* a1 = cA + (size_t)(t + 1) * kstep;
            const char* a2 = last ? nA : cA + (size_t)(t + 2) * kstep; const char* b2 = last ? nB : cB + (size_t)(t + 2) * kstep;
            const char* a3 = a2 + kstep; const char* b3 = b2 + kstep;
            if constexpr (Epi::MIDK) { if (t == (nt >> 1)) E.mid(acc, cur, wr, wc, fr, fq); }
            PG8_LDB(B0, 0, 0); PG8_LDB(B1, 0, 1); PG8_SCHED; PG8_LDA(At, 0, 0); PG8_STAGE(PG8_SA(1, 1), a1 + hA, voffA);
            PG8_WAIT_V(8); PG8_WAIT_L(0); PG8_BAR; PG8_MMA(0, 0, At, B0); PG8_MMA(0, 1, At, B1); PG8_BAR; PG8_SCHED;
            PG8_LDA(At, 0, 1); PG8_STAGE(PG8_SB(0, 0), b2, voffB); PG8_STAGE(PG8_SB(0, 1), b2 + hB, voffB); PG8_STAGE(PG8_SA(0, 0), a2, voffA);
            PG8_WAIT_V(8); PG8_WAIT_L(0); PG8_BAR; PG8_MMA(1, 0, At, B0); PG8_MMA(1, 1, At, B1); PG8_BAR; PG8_SCHED;
            PG8_LDB(B0, 1, 0); PG8_LDB(B1, 1, 1); PG8_SCHED; PG8_LDA(At, 1, 0); PG8_STAGE(PG8_SA(0, 1), a2 + hA, voffA);
            PG8_WAIT_V(8); PG8_WAIT_L(0); PG8_BAR; PG8_MMA(0, 0, At, B0); PG8_MMA(0, 1, At, B1); PG8_BAR; PG8_SCHED;
            PG8_LDA(At, 1, 1); PG8_STAGE(PG8_SB(1, 0), b3, voffB); PG8_STAGE(PG8_SB(1, 1), b3 + hB, voffB); PG8_STAGE(PG8_SA(1, 0), a3, voffA);
            PG8_WAIT_V(8); PG8_WAIT_L(0); PG8_BAR; PG8_MMA(1, 0, At, B0); PG8_MMA(1, 1, At, B1); PG8_BAR; PG8_SCHED;
        }
        if constexpr (ALIGN_EPI) { if (wr == 0) PG8_BAR; }
        E(acc, cur, wr, wc, fr, fq);
        if (!has_next) break;
#pragma unroll
        for (int a = 0; a < 2; ++a)
#pragma unroll
            for (int b = 0; b < 2; ++b)
#pragma unroll
                for (int m = 0; m < 4; ++m)
#pragma unroll
                    for (int n = 0; n < 2; ++n) acc[a][b][m][n] = (f32x4){0.f, 0.f, 0.f, 0.f};
        cur = nxt; cA = nA; cB = nB; ++ui;
        if constexpr (ALIGN_EPI) { if (wr == 1) PG8_BAR; }
    }
    PG8_WAIT_V(0);
    if constexpr (!ALIGN_EPI) { if (wr == 0) PG8_BAR; }
    PG8_BAR;
#undef PG8_SA
#undef PG8_SB
#undef PG8_STAGE
#undef PG8_LDA
#undef PG8_LDB
#undef PG8_MMA
#undef PG8_WAIT_V
#undef PG8_WAIT_L
#undef PG8_BAR
#undef PG8_SCHED
}
}

#define EPI_LOOP(ai, m, bj) _Pragma("unroll") for (int ai = 0; ai < 2; ++ai) _Pragma("unroll") for (int m = 0; m < 4; ++m) _Pragma("unroll") for (int bj = 0; bj < 2; ++bj)

struct EpiIn {
    static constexpr bool MIDK = false;
    bf16_t *UH, *ZS, *Q, *KB, *VB, *ZA, *GS, *GA; float *ock, *ocv; const float *qw, *kw; LAS float* xch;
    __device__ __forceinline__ void operator()(const pg8::Acc& acc, const pg8::Unit& u, int wr, int wc, int fr, int fq) const {
        const int type = u.pn >> 2;
        const int row0 = u.pm * 256 + wr * 64 + fr;
        const int col0 = u.pn * 256 + wc * 32 + 8 * fq;
        if (type == 0) {
            EPI_LOOP(ai, m, bj) { const int tok = row0 + ai * 128 + m * 16, c = col0 + bj * 128; const int g = c >> 4, i0 = c & 15;
                *(u32x4*)(UH + ((size_t)(g * 512 + (tok >> 4)) * 512 + (tok & 15) * 16 + i0)) = pack8(acc[ai][bj][m][0], acc[ai][bj][m][1]); }
        } else if (type == 1 || type == 5) {
            bf16_t* O = (type == 1) ? ZS : ZA; const int cb = (type == 1) ? 1024 : 5120;
            EPI_LOOP(ai, m, bj) { const int tok = row0 + ai * 128 + m * 16, c = col0 + bj * 128 - cb; f32x4 a = acc[ai][bj][m][0], b = acc[ai][bj][m][1];
#pragma unroll
                for (int e = 0; e < 4; ++e) { a[e] = silu_f(a[e]); b[e] = silu_f(b[e]); }
                *(u32x4*)(O + (size_t)tok * 1024 + c) = pack8(a, b); }
        } else if (type >= 6) {
            bf16_t* O = (type < 8) ? GS : GA; const int cb = (type < 8) ? 6144 : 8192;
            EPI_LOOP(ai, m, bj) { const int tok = row0 + ai * 128 + m * 16, c = col0 + bj * 128 - cb; f32x4 a = acc[ai][bj][m][0], b = acc[ai][bj][m][1];
#pragma unroll
                for (int e = 0; e < 4; ++e) { a[e] = sigm_f(a[e]); b[e] = sigm_f(b[e]); }
                *(u32x4*)(O + (size_t)tok * 2048 + c) = pack8(a, b); }
        } else if (type == 4) {
            EPI_LOOP(ai, m, bj) { const int tok = row0 + ai * 128 + m * 16, c = col0 + bj * 128 - 4096; const f32x4 a = acc[ai][bj][m][0], b = acc[ai][bj][m][1];
                { const int hh = c >> 6, d0 = c & 63;
                  *(u32x4*)(VB + (size_t)((tok >> 6) * 16 + hh) * 4096 + ((d0 >> 5) * 4 + ((tok & 63) >> 4)) * 512 + (tok & 15) * 32 + ((d0 & 31) >> 3) * 8) = pack8(a, b); }
                if (tok < NPROMPT) { *(f32x4*)(ocv + (size_t)tok * 1024 + c) = a; *(f32x4*)(ocv + (size_t)tok * 1024 + c + 4) = b; } }
        } else {
            float ss[2][4][2];
            EPI_LOOP(ai, m, bj) { const f32x4 a = acc[ai][bj][m][0], b = acc[ai][bj][m][1];
                float s = (a[0] * a[0] + a[1] * a[1]) + (a[2] * a[2] + a[3] * a[3]) + (b[0] * b[0] + b[1] * b[1]) + (b[2] * b[2] + b[3] * b[3]);
                s += __shfl_xor(s, 16); s += __shfl_xor(s, 32); ss[ai][m][bj] = s;
                if (fq == 0) xch[(ai * 128 + wr * 64 + m * 16 + fr) * 8 + bj * 4 + wc] = s; }
            LDS_WAIT(); __builtin_amdgcn_s_barrier(); asm volatile("" ::: "memory");
            const float* nw = (type == 2) ? qw : kw; const float osc = (type == 2) ? QSCALE : 1.0f;
            const int d0 = (wc & 1) * 32 + 8 * fq;
            const f32x4 w0 = *(const f32x4*)(nw + d0), w1 = *(const f32x4*)(nw + d0 + 4);
            bf16_t* O = (type == 2) ? Q : KB; const int cb = (type == 2) ? 2048 : 3072;
            EPI_LOOP(ai, m, bj) { const int tok = row0 + ai * 128 + m * 16, c = col0 + bj * 128 - cb;
                const float tot = ss[ai][m][bj] + xch[(ai * 128 + wr * 64 + m * 16 + fr) * 8 + bj * 4 + (wc ^ 1)];
                const float rstd = __builtin_amdgcn_rsqf(tot * (1.0f / 64.0f) + EPSN);
                f32x4 a = acc[ai][bj][m][0] * rstd * w0, b = acc[ai][bj][m][1] * rstd * w1;
                if (type == 3 && tok < NPROMPT) { *(f32x4*)(ock + (size_t)tok * 1024 + c) = a; *(f32x4*)(ock + (size_t)tok * 1024 + c + 4) = b; }
                a = a * osc; b = b * osc;
                if (type == 2) *(u32x4*)(O + (size_t)tok * 1024 + c) = pack8(a, b);
                else { const int hh = c >> 6, d0 = c & 63;
                    *(u32x4*)(O + (size_t)((tok >> 6) * 16 + hh) * 4096 + (d0 >> 3) * 512 + (tok & 63) * 8) = pack8(a, b); } }
        }
    }
};

struct EpiS {
    static constexpr bool MIDK = false;
    float* S;
    __device__ __forceinline__ void operator()(const pg8::Acc& acc, const pg8::Unit& u, int wr, int wc, int fr, int fq) const {
        const int row0 = u.pm * 256 + wr * 64 + fr, col0 = wc * 32 + 8 * fq;
        EPI_LOOP(ai, m, bj) { float* p = S + (size_t)(row0 + ai * 128 + m * 16) * 256 + col0 + bj * 128; *(f32x4*)p = acc[ai][bj][m][0]; *(f32x4*)(p + 4) = acc[ai][bj][m][1]; }
    }
};
struct EpiY {
    static constexpr bool MIDK = false;
    bf16_t* YS;
    __device__ __forceinline__ void operator()(const pg8::Acc& acc, const pg8::Unit& u, int wr, int wc, int fr, int fq) const {
        const int g = u.pm >> 1, ch0 = (u.pm & 1) * 256 + wr * 64 + fr, col0 = wc * 32 + 8 * fq;
        EPI_LOOP(ai, m, bj) { const int chunk = ch0 + ai * 128 + m * 16, c = col0 + bj * 128, tau = c >> 4, i0 = c & 15; f32x4 a = acc[ai][bj][m][0], b = acc[ai][bj][m][1];
#pragma unroll
            for (int e = 0; e < 4; ++e) { a[e] = gelu_f(a[e]); b[e] = gelu_f(b[e]); }
            *(u32x4*)(YS + (size_t)(chunk * 16 + tau) * 1024 + g * 16 + i0) = pack8(a, b); }
    }
};
struct EpiGlu {
    static constexpr bool MIDK = false;
    const bf16_t *YS, *ZS; const float* bglu; bf16_t* A2;
    __device__ __forceinline__ void operator()(const pg8::Acc& acc, const pg8::Unit& u, int wr, int wc, int fr, int fq) const {
        const int row0 = u.pm * 256 + wr * 64 + fr, col0 = u.pn * 256 + wc * 32 + 8 * fq;
        f32x4 bb[2][2];
#pragma unroll
        for (int bj = 0; bj < 2; ++bj) { bb[bj][0] = *(const f32x4*)(bglu + col0 + bj * 128); bb[bj][1] = *(const f32x4*)(bglu + col0 + bj * 128 + 4); }
#pragma unroll
        for (int ai = 0; ai < 2; ++ai) {
            u32x4 yv[4][2], zv[4][2];
#pragma unroll
            for (int m = 0; m < 4; ++m)
#pragma unroll
                for (int bj = 0; bj < 2; ++bj) { const size_t off = (size_t)(row0 + ai * 128 + m * 16) * 1024 + col0 + bj * 128; yv[m][bj] = *(const u32x4*)(YS + off); zv[m][bj] = *(const u32x4*)(ZS + off); }
#pragma unroll
            for (int m = 0; m < 4; ++m)
#pragma unroll
                for (int bj = 0; bj < 2; ++bj) { f32x4 y0, y1, z0, z1; unpack8(yv[m][bj], y0, y1); unpack8(zv[m][bj], z0, z1);
                    f32x4 a = acc[ai][bj][m][0] + bb[bj][0], b = acc[ai][bj][m][1] + bb[bj][1];
#pragma unroll
                    for (int e = 0; e < 4; ++e) { a[e] = y0[e] * sigm_f(a[e]) * z0[e]; b[e] = y1[e] * sigm_f(b[e]) * z1[e]; }
                    *(u32x4*)(A2 + (size_t)(row0 + ai * 128 + m * 16) * 2048 + col0 + bj * 128) = pack8(a, b); }
            asm volatile("" ::: "memory");
        }
    }
};
struct EpiMerge {
    static constexpr bool MIDK = true;
    const bf16_t *GS, *GA; bf16_t* MG;
    __device__ __forceinline__ void mid(pg8::Acc& acc, const pg8::Unit& u, int wr, int wc, int fr, int fq) const {
        int row0 = u.pm * 256 + wr * 64 + fr, col0 = u.pn * 256 + wc * 32 + 8 * fq;
        asm volatile("" : "+v"(row0), "+v"(col0));
#pragma unroll
        for (int ai = 0; ai < 2; ++ai) {
            u32x4 gs[4][2], ga[4][2];
#pragma unroll
            for (int m = 0; m < 4; ++m)
#pragma unroll
                for (int bj = 0; bj < 2; ++bj) { const size_t off = (size_t)(row0 + ai * 128 + m * 16) * 2048 + col0 + bj * 128; gs[m][bj] = *(const u32x4*)(GS + off); ga[m][bj] = *(const u32x4*)(GA + off); }
#pragma unroll
            for (int m = 0; m < 4; ++m)
#pragma unroll
                for (int bj = 0; bj < 2; ++bj) { f32x4 s0, s1, a0, a1; unpack8(gs[m][bj], s0, s1); unpack8(ga[m][bj], a0, a1);
#pragma unroll
                    for (int e = 0; e < 4; ++e) { acc[ai][bj][m][0][e] *= s0[e] * __builtin_amdgcn_rcpf(__builtin_fmaxf(a0[e], 1e-30f)); acc[ai][bj][m][1][e] *= s1[e] * __builtin_amdgcn_rcpf(__builtin_fmaxf(a1[e], 1e-30f)); }
                    asm volatile("" : "+v"(acc[ai][bj][m][0]), "+v"(acc[ai][bj][m][1])); }
            asm volatile("" ::: "memory");
        }
    }
    __device__ __forceinline__ void operator()(const pg8::Acc& acc, const pg8::Unit& u, int wr, int wc, int fr, int fq) const {
        const int row0 = u.pm * 256 + wr * 64 + fr, col0 = u.pn * 256 + wc * 32 + 8 * fq;
        u32x4 ga[2][4][2];
        EPI_LOOP(ai, m, bj) ga[ai][m][bj] = *(const u32x4*)(GA + (size_t)(row0 + ai * 128 + m * 16) * 2048 + col0 + bj * 128);
        EPI_LOOP(ai, m, bj) { const size_t off = (size_t)(row0 + ai * 128 + m * 16) * 2048 + col0 + bj * 128;
            f32x4 a0, a1; unpack8(ga[ai][m][bj], a0, a1);
            *(u32x4*)(MG + off) = pack8(acc[ai][bj][m][0] * a0, acc[ai][bj][m][1] * a1); }
    }
};
struct EpiOut {
    static constexpr bool MIDK = false;
    const float *xp, *xs, *mod; float* out;
    __device__ __forceinline__ void operator()(const pg8::Acc& acc, const pg8::Unit& u, int wr, int wc, int fr, int fq) const {
        const int row0 = u.pm * 256 + wr * 64 + fr, col0 = u.pn * 256 + wc * 32 + 8 * fq;
        const int cond = (u.pm < 16) ? 0 : 1 + ((u.pm - 16) >> 3);
        const float* gate = mod + cond * 6144 + 4096;
        const float* xb = (u.pm < 16) ? xp : xs - (size_t)NPROMPT * 2048;
        f32x4 gg[2][2];
#pragma unroll
        for (int bj = 0; bj < 2; ++bj) { gg[bj][0] = *(const f32x4*)(gate + col0 + bj * 128); gg[bj][1] = *(const f32x4*)(gate + col0 + bj * 128 + 4); }
#pragma unroll
        for (int ai = 0; ai < 2; ++ai)
#pragma unroll
            for (int mh = 0; mh < 2; ++mh) {
                f32x4 xv[2][2][2];
#pragma unroll
                for (int mm = 0; mm < 2; ++mm)
#pragma unroll
                    for (int bj = 0; bj < 2; ++bj) { const float* xr = xb + (size_t)(row0 + ai * 128 + (mh * 2 + mm) * 16) * 2048 + col0 + bj * 128; xv[mm][bj][0] = *(const f32x4*)xr; xv[mm][bj][1] = *(const f32x4*)(xr + 4); }
#pragma unroll
                for (int mm = 0; mm < 2; ++mm)
#pragma unroll
                    for (int bj = 0; bj < 2; ++bj) { const int m = mh * 2 + mm; float* o = out + (size_t)(row0 + ai * 128 + m * 16) * 2048 + col0 + bj * 128;
                        *(f32x4*)o = xv[mm][bj][0] + gg[bj][0] * acc[ai][bj][m][0]; *(f32x4*)(o + 4) = xv[mm][bj][1] + gg[bj][1] * acc[ai][bj][m][1]; }
                asm volatile("" ::: "memory");
            }
    }
};

#define XB_TMO      128
#define XB_XCNT(j)  (256  + 64 * (j))
#define XB_XSUB(j)  (1280 + 64 * (j))
#define XB_XGEN(j)  (2304 + 64 * (j))
#define XB_TOP      3328
#define XB_TOPGEN   3392
#define XCD_BAR_WORDS 3456
#define XB_SPIN_CAP (1u << 20)
__device__ __forceinline__ unsigned xb_ld(unsigned* p)              { return __hip_atomic_load(p, __ATOMIC_RELAXED, __HIP_MEMORY_SCOPE_AGENT); }
__device__ __forceinline__ unsigned xb_add(unsigned* p, unsigned v) { return __hip_atomic_fetch_add(p, v, __ATOMIC_RELAXED, __HIP_MEMORY_SCOPE_AGENT); }
__device__ __forceinline__ unsigned xb_xcc_id() { return (unsigned)__builtin_amdgcn_s_getreg((3 << 11) | 20) & 0xFu; }
#define XB_SPIN(cond, bar) do { unsigned _sp = 0; while (cond) { __builtin_amdgcn_s_sleep(1); \
    if ((++_sp & 255u) == 0u) { if (xb_ld(&(bar)[XB_TMO])) break; if (_sp > XB_SPIN_CAP) { atomicAdd(&(bar)[XB_TMO], 1u); break; } } } } while (0)
struct XcdBarrier { unsigned* bar; unsigned x; volatile LAS unsigned* st; };
__device__ __forceinline__ XcdBarrier xcd_barrier_post(unsigned* bar, volatile LAS unsigned* st) {
    XcdBarrier b; b.bar = bar; b.x = xb_xcc_id(); b.st = st;
    if (threadIdx.x == 0) (void)xb_add(&bar[XB_XCNT(b.x)], 1u);
    return b;
}
__device__ __forceinline__ void xcd_barrier_complete(unsigned* bar, unsigned x, unsigned& nloc, unsigned& nx) {
    const unsigned G = gridDim.x * gridDim.y * gridDim.z;
    unsigned sum, cnt, mine, sp = 0u;
    for (;;) {
        sum = 0u; cnt = 0u; mine = 0u;
#pragma unroll
        for (unsigned j = 0; j < 16; ++j) { const unsigned c = xb_ld(&bar[XB_XCNT(j)]); sum += c; cnt += (c > 0u) ? 1u : 0u; mine = (j == x) ? c : mine; }
        if (sum == G) break;
        __builtin_amdgcn_s_sleep(1);
        if ((++sp & 255u) == 0u) { if (xb_ld(&bar[XB_TMO])) break; if (sp > XB_SPIN_CAP) { atomicAdd(&bar[XB_TMO], 1u); break; } }
    }
    nloc = mine > 0u ? mine : 1u; nx = cnt > 0u ? cnt : 1u;
}
__device__ __forceinline__ void xcd_barrier(const XcdBarrier& b) {
    asm volatile("s_waitcnt vmcnt(0)" ::: "memory");
    __syncthreads();
    if (threadIdx.x == 0) {
        unsigned* bar = b.bar;
        __builtin_amdgcn_s_waitcnt(0);
        unsigned nloc = b.st[0], nx = b.st[1];
        if (nloc == 0u) { xcd_barrier_complete(bar, b.x, nloc, nx); b.st[0] = nloc; b.st[1] = nx; }
        const unsigned old = xb_add(&bar[XB_XSUB(b.x)], 1u);
        const unsigned gen = old / nloc;
        if (old + 1u == (gen + 1u) * nloc) {
            __builtin_amdgcn_fence(__ATOMIC_RELEASE, "agent");
            asm volatile("s_waitcnt vmcnt(0)" ::: "memory");
            const unsigned og = xb_add(&bar[XB_TOP], 1u);
            const unsigned tg = og / nx;
            if (og + 1u == (tg + 1u) * nx) xb_add(&bar[XB_TOPGEN], 1u);
            else XB_SPIN(xb_ld(&bar[XB_TOPGEN]) == tg, bar);
            __builtin_amdgcn_fence(__ATOMIC_ACQUIRE, "agent");
            xb_add(&bar[XB_XGEN(b.x)], 1u);
            asm volatile("s_waitcnt vmcnt(0)" ::: "memory");
        } else {
            XB_SPIN(xb_ld(&bar[XB_XGEN(b.x)]) == gen, bar);
            __builtin_amdgcn_fence(__ATOMIC_ACQUIRE, "agent");
            asm volatile("s_waitcnt vmcnt(0)" ::: "memory");
        }
    }
    __syncthreads();
}

struct Args { const float* in[28]; float* out; unsigned char* ws; int ph_lo, ph_hi; };
typedef const __attribute__((address_space(4))) Args* KP;
__device__ __forceinline__ KP fresh_kp() { KP kp = (KP)__builtin_amdgcn_kernarg_segment_ptr(); asm volatile("" : "+s"(kp)); return kp; }
enum { I_XP = 0, I_XS, I_CK, I_CV, I_SRE, I_SIM, I_C, I_CCTX, I_NORMW, I_WADA, I_BADA, I_WIN, I_QNW, I_KNW, I_RPB, I_ARE, I_AIM, I_LOGDT, I_BRE, I_BIM, I_CRE, I_CIM, I_D, I_WGLU, I_BGLU, I_WSSM, I_WATT, I_WO };

__device__ __forceinline__ void p0_transpose_item(const float* W, int N, bf16_t* WT, int ldt, int koff, LAS float* scr, int item, int lane) {
    const int nblk = N / 64, kb = item / nblk, nb = item % nblk, k0 = 64 * kb, n0 = 64 * nb;
    const int c16 = lane & 15, r4 = lane >> 4;
    f32x4 v[16];
#pragma unroll
    for (int i = 0; i < 16; ++i) v[i] = *(const f32x4*)(W + (size_t)(k0 + 4 * i + r4) * N + n0 + 4 * c16);
#pragma unroll
    for (int i = 0; i < 16; ++i) { LAS float* d = scr + (4 * i + r4) * 65 + 4 * c16; d[0] = v[i][0]; d[1] = v[i][1]; d[2] = v[i][2]; d[3] = v[i][3]; }
    LDS_WAIT(); asm volatile("" ::: "memory");
    const int c = lane & 7;
#pragma unroll
    for (int j = 0; j < 8; ++j) { const int n = (lane >> 3) + 8 * j; const LAS float* sp = scr + (8 * c) * 65 + n;
        u32x4 o; o.x = cvtpk(sp[0 * 65], sp[1 * 65]); o.y = cvtpk(sp[2 * 65], sp[3 * 65]); o.z = cvtpk(sp[4 * 65], sp[5 * 65]); o.w = cvtpk(sp[6 * 65], sp[7 * 65]);
        *(u32x4*)(WT + (size_t)(n0 + n) * ldt + koff + k0 + 8 * c) = o; }
    LDS_WAIT(); asm volatile("" ::: "memory");
}

__device__ __forceinline__ void p0_ssm_prep(KP A, LAS float* sc, int g, int qt, int tid) {
    LAS float* LPr = sc;
    LAS float* LPi = sc + 2176;
    LAS float* BBr = sc + 4352;
    LAS float* BBi = sc + 6400;
    LAS float* CCr = sc + 8448;
    LAS float* CCi = sc + 10496;
    LAS float* KT = sc + 12544;
    LAS float* COr = sc + 14592;
    LAS float* COi = sc + 14720;
    const float* a_re = A->in[I_ARE]; const float* a_im = A->in[I_AIM]; const float* logdt = A->in[I_LOGDT];
    {
        const int d = (tid >> 6) & 1, p = tid & 63, slot = tid >> 7;
        const float are = __builtin_fminf(a_re[(d * 64 + g) * 64 + p], -1e-4f), aim = a_im[(d * 64 + g) * 64 + p];
        const float dt = __expf(logdt[d * 64 + g]);
        const float zr = are * dt, zi = aim * dt;
#pragma unroll 1
        for (int e = slot; e <= 16; e += 4) { float sn, cn; sincos_rad((float)e * zi, sn, cn); const float mg = __expf((float)e * zr); LPr[(d * 17 + e) * 64 + p] = mg * cn; LPi[(d * 17 + e) * 64 + p] = mg * sn; }
        if (slot == 0) {
            float s1, c1, sh, chh; sincos_rad(zi, s1, c1); sincos_rad(0.5f * zi, sh, chh); (void)chh;
            const float em1 = expm1f(zr), mg = em1 + 1.0f;
            const float nr = em1 * c1 - 2.0f * sh * sh, ni = mg * s1;
            const float den = 1.0f / (are * are + aim * aim);
            COr[d * 64 + p] = (nr * are + ni * aim) * den; COi[d * 64 + p] = (ni * are - nr * aim) * den;
        }
    }
    __syncthreads();
    {
        const float* b_re = A->in[I_BRE]; const float* b_im = A->in[I_BIM]; const float* c_re = A->in[I_CRE]; const float* c_im = A->in[I_CIM];
#pragma unroll
        for (int n = 0; n < 4; ++n) { const int idx = tid + 512 * n, d = idx >> 10, p = (idx >> 4) & 63;
            const float br = b_re[((size_t)(d * 64 + g) * 64) * 16 + (idx & 1023)], bi = b_im[((size_t)(d * 64 + g) * 64) * 16 + (idx & 1023)];
            const float cr = COr[d * 64 + p], ci = COi[d * 64 + p];
            BBr[idx] = cr * br - ci * bi; BBi[idx] = cr * bi + ci * br; }
#pragma unroll
        for (int n = 0; n < 4; ++n) { const int idx = tid + 512 * n, d = idx >> 10, i = (idx >> 6) & 15, p = idx & 63;
            CCr[(d * 64 + p) * 16 + i] = c_re[((size_t)(d * 64 + g) * 16 + i) * 64 + p]; CCi[(d * 64 + p) * 16 + i] = c_im[((size_t)(d * 64 + g) * 16 + i) * 64 + p]; }
    }
    __syncthreads();
    {
        const int d = tid >> 8, dloc = (tid >> 6) & 3, i = (tid >> 2) & 15, jq = tid & 3, dl = 4 * qt + dloc;
        f32x4 acc = {0.f, 0.f, 0.f, 0.f};
#pragma unroll 4
        for (int p = 0; p < 64; ++p) {
            const float cr = CCr[(d * 64 + p) * 16 + i], ci = CCi[(d * 64 + p) * 16 + i], lr = LPr[(d * 17 + dl) * 64 + p], li = LPi[(d * 17 + dl) * 64 + p];
            const float tr = cr * lr - ci * li, ti = cr * li + ci * lr;
            const f32x4 br = *(const LAS f32x4*)(BBr + (d * 64 + p) * 16 + 4 * jq), bi = *(const LAS f32x4*)(BBi + (d * 64 + p) * 16 + 4 * jq);
            acc += tr * br - ti * bi;
        }
        *(LAS f32x4*)(KT + (d * 4 + dloc) * 256 + i * 16 + 4 * jq) = acc;
    }
    __syncthreads();
    bf16_t* WA = (bf16_t*)(A->ws + WS_WA) + (size_t)g * 256 * 256;
    bf16_t* WOS = (bf16_t*)(A->ws + WS_WOS) + (size_t)g * 256 * 512;
#pragma unroll 1
    for (int it = 0; it < 4; ++it) {
        const int q = it * 512 + tid, n = 64 * qt + (q >> 5), s = (q >> 1) & 15, jh = q & 1, d = n >> 7, ri = (n >> 6) & 1, p = n & 63;
        const int e = (d == 0) ? 15 - s : s;
        const float lr = LPr[(d * 17 + e) * 64 + p], li = LPi[(d * 17 + e) * 64 + p];
        const f32x4 br0 = *(const LAS f32x4*)(BBr + (d * 64 + p) * 16 + jh * 8), br1 = *(const LAS f32x4*)(BBr + (d * 64 + p) * 16 + jh * 8 + 4);
        const f32x4 bi0 = *(const LAS f32x4*)(BBi + (d * 64 + p) * 16 + jh * 8), bi1 = *(const LAS f32x4*)(BBi + (d * 64 + p) * 16 + jh * 8 + 4);
        const f32x4 v0 = ri == 0 ? lr * br0 - li * bi0 : lr * bi0 + li * br0, v1 = ri == 0 ? lr * br1 - li * bi1 : lr * bi1 + li * br1;
        *(u32x4*)(WA + (size_t)n * 256 + s * 16 + jh * 8) = pack8(v0, v1);
    }
    const float* dsk = A->in[I_D];
#pragma unroll 1
    for (int it = 0; it < 8; ++it) {
        const int q = it * 512 + tid, n = q >> 4, sidx = (q >> 1) & 7, jh = q & 1, tau = n >> 4, i = n & 15;
        int s, dd, dloc;
        if (sidx < 4) { dloc = 3 - sidx; s = tau - 4 * qt - dloc; dd = 0; } else { dloc = sidx - 4; s = tau + 4 * qt + dloc; dd = 1; }
        const bool diag = (qt == 0 && dloc == 0);
        if (s < 0 || s > 15 || (diag && dd == 1)) continue;
        const LAS float* kp = KT + (dd * 4 + dloc) * 256 + i * 16 + jh * 8;
        f32x4 v0 = *(const LAS f32x4*)kp, v1 = *(const LAS f32x4*)(kp + 4);
        if (diag) { const LAS float* k2 = KT + (1 * 4 + 0) * 256 + i * 16 + jh * 8; v0 += *(const LAS f32x4*)k2; v1 += *(const LAS f32x4*)(k2 + 4);
            const float dv = dsk[g * 16 + i]; const int jj = i - jh * 8;
            if (jj >= 0 && jj < 4) v0[jj] += dv; else if (jj >= 4 && jj < 8) v1[jj - 4] += dv; }
        *(u32x4*)(WOS + (size_t)n * 512 + s * 16 + jh * 8) = pack8(v0, v1);
    }
#pragma unroll 1
    for (int it = 0; it < 4; ++it) {
        const int q = it * 512 + tid, n = 64 * qt + (q >> 5), pc = q & 31, tau = n >> 4, i = n & 15;
        const int kk = pc * 8, d = kk >> 7, ri = (kk >> 6) & 1, p0 = kk & 63, f = (d == 0) ? tau + 1 : 16 - tau;
        float v[8];
#pragma unroll
        for (int jj = 0; jj < 8; ++jj) { const int p = p0 + jj; const float cr = CCr[(d * 64 + p) * 16 + i], ci = CCi[(d * 64 + p) * 16 + i], lr = LPr[(d * 17 + f) * 64 + p], li = LPi[(d * 17 + f) * 64 + p];
            v[jj] = ri == 0 ? cr * lr - ci * li : -(cr * li + ci * lr); }
        u32x4 o; o.x = cvtpk(v[0], v[1]); o.y = cvtpk(v[2], v[3]); o.z = cvtpk(v[4], v[5]); o.w = cvtpk(v[6], v[7]);
        *(u32x4*)(WOS + (size_t)n * 512 + 256 + pc * 8) = o;
    }
    __syncthreads();
}

__device__ __forceinline__ void p0_gemv_strip(KP A, LAS float* sc, int s, int tid) {
    LAS float* cs = sc;
    LAS float* red = sc + 6144;
    const float* cctx = A->in[I_CCTX]; const float* c = A->in[I_C];
    for (int i = tid; i < 6144; i += 512) { const float v = (i < 2048) ? cctx[i] : c[i - 2048]; cs[i] = silu_f(v); }
    __syncthreads();
    const int wid = tid >> 6, lane = tid & 63, kk = lane >> 3, c4 = lane & 7;
    const float* W = A->in[I_WADA] + (size_t)(256 * wid + kk) * 6144 + 32 * s + 4 * c4;
    f32x4 a0 = {0.f, 0.f, 0.f, 0.f}, a1 = a0, a2 = a0;
#pragma unroll 32
    for (int it = 0; it < 32; ++it) { const f32x4 w = *(const f32x4*)(W + (size_t)it * 8 * 6144); const int k = 256 * wid + 8 * it + kk;
        a0 += cs[k] * w; a1 += cs[2048 + k] * w; a2 += cs[4096 + k] * w; }
#pragma unroll
    for (int e = 0; e < 4; ++e) {
#pragma unroll
        for (int o = 8; o < 64; o <<= 1) { a0[e] += __shfl_xor(a0[e], o); a1[e] += __shfl_xor(a1[e], o); a2[e] += __shfl_xor(a2[e], o); }
    }
    if (kk == 0) {
#pragma unroll
        for (int e = 0; e < 4; ++e) { red[(wid * 3 + 0) * 32 + c4 * 4 + e] = a0[e]; red[(wid * 3 + 1) * 32 + c4 * 4 + e] = a1[e]; red[(wid * 3 + 2) * 32 + c4 * 4 + e] = a2[e]; }
    }
    __syncthreads();
    if (tid < 96) { const int cnd = tid >> 5, col = tid & 31; float v = A->in[I_BADA][32 * s + col];
#pragma unroll
        for (int w = 0; w < 8; ++w) v += red[(w * 3 + cnd) * 32 + col];
        ((float*)(A->ws + WS_MOD))[cnd * 6144 + 32 * s + col] = v; }
    __syncthreads();
}

constexpr int CW_GEMV = 64, CW_ATT = 128, CW_SSM0 = 192, CW_SSM1 = 256;
__device__ __forceinline__ void phase1(KP A, int lane, int wave);
__device__ __forceinline__ void phase0(KP A, LAS unsigned char* lds, int tid, int lane, int wave) {
    const int bx = blockIdx.x, G = gridDim.x;
    unsigned* cnt = (unsigned*)(A->ws + WS_CTL) + CW_GEMV;
#ifndef SUBDUP
#define SUBDUP 0
#endif
    LAS float* scr = (LAS float*)(lds + wave * 16640);
    const int gw = bx * NWAVES + wave, NGW = G * NWAVES;
    constexpr int I_IN = 32 * 160, I_GLU = 16 * 16, I_SO = 16 * 32, I_AO = 16 * 32, I_O = 32 * 32, NITEMS = I_IN + I_GLU + I_SO + I_AO + I_O;
#pragma unroll 1
    for (int step = 0; step < 3; ++step) {
        const int what = (bx & 1) ? (step == 0 ? 2 : step - 1) : step;
        if (what == 0) {
            for (int t = bx; t < 192; t += G) {
                p0_gemv_strip(A, (LAS float*)lds, t, tid);
                VM_WAIT(); __syncthreads();
                if (tid == 0) { __builtin_amdgcn_fence(__ATOMIC_RELEASE, "agent"); VM_WAIT(); __hip_atomic_fetch_add(cnt, 1u, __ATOMIC_RELAXED, __HIP_MEMORY_SCOPE_AGENT); }
            }
        } else if (what == 1) {
            __syncthreads();
            for (int it = gw; it < NITEMS; it += NGW) {
                int r = it;
                if (r < I_IN) { p0_transpose_item(A->in[I_WIN], INW, (bf16_t*)(A->ws + WS_WIN), 2048, 0, scr, r, lane); continue; } r -= I_IN;
                if (r < I_GLU) { p0_transpose_item(A->in[I_WGLU], 1024, (bf16_t*)(A->ws + WS_WGLU), 1024, 0, scr, r, lane); continue; } r -= I_GLU;
                if (r < I_SO) { p0_transpose_item(A->in[I_WSSM], 2048, (bf16_t*)(A->ws + WS_WM), 2048, 0, scr, r, lane); continue; } r -= I_SO;
                if (r < I_AO) { p0_transpose_item(A->in[I_WATT], 2048, (bf16_t*)(A->ws + WS_WM), 2048, 1024, scr, r, lane); continue; } r -= I_AO;
                p0_transpose_item(A->in[I_WO], 2048, (bf16_t*)(A->ws + WS_WO), 2048, 0, scr, r, lane);
            }
            __syncthreads();
        } else {
            for (int t = bx; t < 256; t += G) p0_ssm_prep(A, (LAS float*)lds, t >> 2, t & 3, tid);
        }
    }
    {
        const int gt = bx * 512 + tid, NT = G * 512;
        for (int i = gt; i < 2 * 131072; i += NT) {
            const int which = i >> 17, j = i & 131071;
            const float* src = A->in[which ? I_CV : I_CK] + (size_t)j * 8;
            const f32x4 a = *(const f32x4*)src, b = *(const f32x4*)(src + 4);
            const int row = j >> 7, hh = (j >> 3) & 15, d0 = (j & 7) * 8;
            const size_t img = (size_t)((row >> 6) * 16 + hh) * 4096;
            const size_t off = which ? img + ((d0 >> 5) * 4 + ((row & 63) >> 4)) * 512 + (row & 15) * 32 + ((d0 & 31) >> 3) * 8 : img + (d0 >> 3) * 512 + (row & 63) * 8;
            *(u32x4*)((bf16_t*)(A->ws + (which ? WS_CV : WS_CK)) + off) = pack8(a, b);
        }
    }
    if (tid == 0) {
        unsigned sp = 0;
        while (__hip_atomic_load(cnt, __ATOMIC_RELAXED, __HIP_MEMORY_SCOPE_AGENT) < 192u) { __builtin_amdgcn_s_sleep(2); if (++sp > (1u << 22)) break; }
        __builtin_amdgcn_fence(__ATOMIC_ACQUIRE, "agent");
        VM_WAIT();
    }
    __syncthreads();
    _Pragma("unroll 1") for (int sd_ = 0; sd_ < 1 + ((SUBDUP >> 3) & 1); ++sd_)
    phase1(A, lane, wave);
}

__device__ __forceinline__ void phase1(KP A, int lane, int wave) {
    const int gw = blockIdx.x * NWAVES + wave, NGW = gridDim.x * NWAVES;
    const float* mod = (const float*)(A->ws + WS_MOD); const float* nw = A->in[I_NORMW];
    bf16_t* XN = (bf16_t*)(A->ws + WS_XN);
    for (int m = gw; m < NTOK; m += NGW) {
        const float* xr = (m < NPROMPT) ? A->in[I_XP] + (size_t)m * 2048 : A->in[I_XS] + (size_t)(m - NPROMPT) * 2048;
        const int cond = (m < NPROMPT) ? 0 : 1 + ((m - NPROMPT) >> 11);
        const float* sh = mod + cond * 6144; const float* scl = sh + 2048;
        f32x4 v[8]; float s = 0.f;
#pragma unroll
        for (int j = 0; j < 8; ++j) { v[j] = *(const f32x4*)(xr + 4 * lane + 256 * j); s += (v[j][0] * v[j][0] + v[j][1] * v[j][1]) + (v[j][2] * v[j][2] + v[j][3] * v[j][3]); }
        const float rstd = __builtin_amdgcn_rsqf(wave_sum(s) * (1.0f / 2048.0f) + EPSN);
#pragma unroll
        for (int j = 0; j < 8; ++j) { const int c = 4 * lane + 256 * j; const f32x4 w = *(const f32x4*)(nw + c), a = *(const f32x4*)(scl + c), b = *(const f32x4*)(sh + c);
            const f32x4 o = (v[j] * rstd * w) * (a + 1.0f) + b; u32x2 pk; pk.x = cvtpk(o[0], o[1]); pk.y = cvtpk(o[2], o[3]);
            *(u32x2*)(XN + (size_t)m * 2048 + c) = pk; }
    }
}

__device__ __forceinline__ void ssm_scan_unit(KP A, LAS unsigned char* lds, int L, int tid) {
    const int g = L >> 1, hf = L & 1;
    const int p = tid & 63, d = (tid >> 6) & 1, sq = tid >> 7;
    LAS float* El = (LAS float*)lds;
    LAS float* Cl = (LAS float*)(lds + 16384);
    const float are = __builtin_fminf(A->in[I_ARE][(d * 64 + g) * 64 + p], -1e-4f), aim = A->in[I_AIM][(d * 64 + g) * 64 + p];
    const float dt = __expf(A->in[I_LOGDT][d * 64 + g]);
    float ls, lc; sincos_rad(16.0f * aim * dt, ls, lc); const float mg = __expf(16.0f * are * dt);
    const float lr = mg * lc, li = mg * ls;
    const float* S = (const float*)(A->ws + WS_S) + (size_t)L * 256 * 256 + d * 128 + p;
    float sr[4][16], si[4][16];
#pragma unroll
    for (int k = 0; k < 4; ++k)
#pragma unroll
        for (int j = 0; j < 16; ++j) { const int row = (sq + 4 * k) * 16 + j; sr[k][j] = S[(size_t)row * 256]; si[k][j] = S[(size_t)row * 256 + 64]; }
    if (hf) {
#pragma unroll
        for (int k = 0; k < 4; ++k) { float er = 0.f, ei = 0.f;
#pragma unroll
            for (int jj = 0; jj < 16; ++jj) { const int j = d ? 15 - jj : jj; const float nr = lr * er - li * ei + sr[k][j], ni = lr * ei + li * er + si[k][j]; er = nr; ei = ni; }
            const int sg = sq + 4 * k; El[(sg * 128 + d * 64 + p) * 2] = er; El[(sg * 128 + d * 64 + p) * 2 + 1] = ei; }
        __syncthreads();
        if (tid < 256) {
            const int sb = tid >> 7;
            float l16r = lr, l16i = li;
#pragma unroll
            for (int q = 0; q < 4; ++q) { const float nr = l16r * l16r - l16i * l16i, ni = 2.0f * l16r * l16i; l16r = nr; l16i = ni; }
            float cr = A->in[I_SRE][((sb * 2 + d) * 64 + g) * 64 + p], ci = A->in[I_SIM][((sb * 2 + d) * 64 + g) * 64 + p];
#pragma unroll
            for (int q = 0; q < 8; ++q) { const int sg = sb * 8 + (d ? 7 - q : q); const int ix = (sg * 128 + d * 64 + p) * 2;
                Cl[ix] = cr; Cl[ix + 1] = ci; const float er = El[ix], ei = El[ix + 1];
                const float nr = l16r * cr - l16i * ci + er, ni = l16r * ci + l16i * cr + ei; cr = nr; ci = ni; }
        }
        __syncthreads();
    }
    bf16_t* H = (bf16_t*)(A->ws + WS_UH) + (size_t)L * 256 * 512 + 256 + d * 128 + p;
#pragma unroll
    for (int k = 0; k < 4; ++k) { const int sg = sq + 4 * k;
        float hr = 0.f, hi = 0.f;
        if (hf) { hr = Cl[(sg * 128 + d * 64 + p) * 2]; hi = Cl[(sg * 128 + d * 64 + p) * 2 + 1]; }
#pragma unroll
        for (int jj = 0; jj < 16; ++jj) { const int j = d ? 15 - jj : jj; const size_t row = (size_t)(sg * 16 + j);
            H[row * 512] = (bf16_t)(cvtpk(hr, 0.f) & 0xffffu); H[row * 512 + 64] = (bf16_t)(cvtpk(hi, 0.f) & 0xffffu);
            const float nr = lr * hr - li * hi + sr[k][j], ni = lr * hi + li * hr + si[k][j]; hr = nr; hi = ni; }
        if (!hf) { A->out[OUT_SRE + ((size_t)(sg * 2 + d) * 64 + g) * 64 + p] = hr; A->out[OUT_SIM + ((size_t)(sg * 2 + d) * 64 + g) * 64 + p] = hi; }
    }
}

namespace att {
constexpr int NSLOT = 4, SLOT = 16384;
constexpr int RING = 0, WSF = 65536, STG = 67584, BIAS = 100352;
constexpr float THR = 8.0f;
__device__ __forceinline__ int crow(int r, int hi) { return (r & 3) + 8 * (r >> 2) + 4 * hi; }
__device__ __forceinline__ constexpr int ccol(int r) { return (r & 3) + 8 * (r >> 2); }
__device__ __forceinline__ s16x4 vtr(const LAS unsigned char* p) { return __builtin_bit_cast(s16x4, __builtin_amdgcn_ds_read_tr16_b64_v4i16((LAS s16x4*)p)); }
#define MX3(a, b, c) __builtin_fmaxf(__builtin_fmaxf((a), (b)), (c))

template <int MODE>
__device__ __forceinline__ void tile(const LAS unsigned char* slot, const bf16x8 (&qr)[4], f32x16& negm, float& mhat, float& lrun, f32x16& o0, f32x16& o1,
                                     LAS float* wsf, const LAS float* brow, const float (&m20)[20], int r32, int hi, int lane, bool first) {
    constexpr int P0_LO = (MODE == 2) ? 12 : 0, P1_HI = (MODE == 1) ? 4 : 16;
    f32x16 p0, p1;
    { const LAS unsigned char* kb = slot + hi * 1024 + r32 * 16;
#pragma unroll
      for (int d0 = 0; d0 < 4; ++d0) { const bf16x8 b0 = *(const LAS bf16x8*)(kb + d0 * 2048), b1 = *(const LAS bf16x8*)(kb + d0 * 2048 + 512);
          if (d0 == 0) { p0 = __builtin_amdgcn_mfma_f32_32x32x16_bf16(b0, qr[0], negm, 0, 0, 0); p1 = __builtin_amdgcn_mfma_f32_32x32x16_bf16(b1, qr[0], negm, 0, 0, 0); }
          else { p0 = __builtin_amdgcn_mfma_f32_32x32x16_bf16(b0, qr[d0], p0, 0, 0, 0); p1 = __builtin_amdgcn_mfma_f32_32x32x16_bf16(b1, qr[d0], p1, 0, 0, 0); } } }
    if (MODE != 0) {
#pragma unroll
        for (int rr = P0_LO; rr < 16; ++rr) p0[rr] += brow[ccol(rr)] + m20[MODE == 1 ? rr : rr - 12];
#pragma unroll
        for (int rr = 0; rr < P1_HI; ++rr) p1[rr] += brow[32 + ccol(rr)] + m20[MODE == 1 ? 16 + rr : 4 + rr];
    }
    float ra, rb;
    if (MODE == 0) { ra = MX3(p0[0], p0[1], p1[0]); rb = MX3(p0[2], p0[3], p1[1]); ra = MX3(ra, p1[2], p1[3]);
#pragma unroll
        for (int r = 4; r < 16; r += 4) { ra = MX3(ra, p0[r], p0[r + 1]); rb = MX3(rb, p0[r + 2], p0[r + 3]); ra = MX3(ra, p1[r], p1[r + 1]); rb = MX3(rb, p1[r + 2], p1[r + 3]); } }
    else if (MODE == 1) { ra = MX3(p0[0], p0[1], p1[0]); rb = MX3(p0[2], p0[3], p1[1]); ra = MX3(ra, p1[2], p1[3]);
#pragma unroll
        for (int r = 4; r < 16; r += 4) { ra = MX3(ra, p0[r], p0[r + 1]); rb = MX3(rb, p0[r + 2], p0[r + 3]); } }
    else { ra = MX3(p1[0], p1[1], p0[12]); rb = MX3(p1[2], p1[3], p0[13]); ra = MX3(ra, p0[14], p0[15]);
#pragma unroll
        for (int r = 4; r < 16; r += 4) { ra = MX3(ra, p1[r], p1[r + 1]); rb = MX3(rb, p1[r + 2], p1[r + 3]); } }
    float rm = __builtin_fmaxf(ra, rb);
    rm = __builtin_fmaxf(rm, __shfl_xor(rm, 32));
    if (first || __any(rm > THR)) {
        const float dl = first ? rm : __builtin_fmaxf(rm, 0.f);
        mhat += dl;
#pragma unroll
        for (int rr = P0_LO; rr < 16; ++rr) p0[rr] -= dl;
#pragma unroll
        for (int rr = 0; rr < P1_HI; ++rr) p1[rr] -= dl;
#pragma unroll
        for (int rr = 0; rr < 16; ++rr) negm[rr] = -mhat;
        const float f = __builtin_amdgcn_exp2f(-dl);
        lrun *= f;
        if (hi == 0) wsf[r32] = f;
        LDS_WAIT();
#pragma unroll
        for (int rr = 0; rr < 16; ++rr) { const float ff = wsf[crow(rr, hi)]; o0[rr] *= ff; o1[rr] *= ff; }
    }
    float sa = 0.f, sb = 0.f;
#pragma unroll
    for (int rr = P0_LO; rr < 16; rr += 2) { p0[rr] = __builtin_amdgcn_exp2f(p0[rr]); p0[rr + 1] = __builtin_amdgcn_exp2f(p0[rr + 1]); sa += p0[rr]; sb += p0[rr + 1]; }
#pragma unroll
    for (int rr = 0; rr < P1_HI; rr += 2) { p1[rr] = __builtin_amdgcn_exp2f(p1[rr]); p1[rr + 1] = __builtin_amdgcn_exp2f(p1[rr + 1]); sa += p1[rr]; sb += p1[rr + 1]; }
    lrun += sa + sb;
    u32x4 pw[4];
    if (MODE == 2) { pw[0] = (u32x4){0u, 0u, 0u, 0u}; pw[1] = (u32x4){0u, 0u, cvtpk(p0[12], p0[13]), cvtpk(p0[14], p0[15])}; }
    else { pw[0] = (u32x4){cvtpk(p0[0], p0[1]), cvtpk(p0[2], p0[3]), cvtpk(p0[4], p0[5]), cvtpk(p0[6], p0[7])};
           pw[1] = (u32x4){cvtpk(p0[8], p0[9]), cvtpk(p0[10], p0[11]), cvtpk(p0[12], p0[13]), cvtpk(p0[14], p0[15])}; }
    if (MODE == 1) { pw[2] = (u32x4){cvtpk(p1[0], p1[1]), cvtpk(p1[2], p1[3]), 0u, 0u}; pw[3] = (u32x4){0u, 0u, 0u, 0u}; }
    else { pw[2] = (u32x4){cvtpk(p1[0], p1[1]), cvtpk(p1[2], p1[3]), cvtpk(p1[4], p1[5]), cvtpk(p1[6], p1[7])};
           pw[3] = (u32x4){cvtpk(p1[8], p1[9]), cvtpk(p1[10], p1[11]), cvtpk(p1[12], p1[13]), cvtpk(p1[14], p1[15])}; }
    const LAS unsigned char* vp = slot + 8192 + ((lane >> 4) & 1) * 32 + (lane & 3) * 8 + (4 * hi + ((lane & 15) >> 2)) * 64;
    constexpr int K_LO = (MODE == 2) ? 1 : 0, K_HI = (MODE == 1) ? 3 : 4;
#pragma unroll
    for (int k = K_LO; k < K_HI; ++k) {
        const s16x4 l0 = vtr(vp + k * 1024), h0 = vtr(vp + k * 1024 + 512), l1 = vtr(vp + 4096 + k * 1024), h1 = vtr(vp + 4096 + k * 1024 + 512);
        const bf16x8 v0 = (bf16x8){l0[0], l0[1], l0[2], l0[3], h0[0], h0[1], h0[2], h0[3]}, v1 = (bf16x8){l1[0], l1[1], l1[2], l1[3], h1[0], h1[1], h1[2], h1[3]};
        const bf16x8 pa = __builtin_bit_cast(bf16x8, pw[k]);
        o0 = __builtin_amdgcn_mfma_f32_32x32x16_bf16(pa, v0, o0, 0, 0, 0); o1 = __builtin_amdgcn_mfma_f32_32x32x16_bf16(pa, v1, o1, 0, 0, 0);
    }
}

template <bool NA>
__device__ __forceinline__ void unit(KP A, LAS unsigned char* lds, int un, int tid_in) {
    int tid = tid_in; asm volatile("" : "+v"(tid));
    const int lane = tid & 63, r32 = lane & 31, hi = lane >> 5, wid = __builtin_amdgcn_readfirstlane(tid >> 6);
    const bf16_t* Q = (const bf16_t*)(A->ws + WS_Q); const bf16_t* KBp = (const bf16_t*)(A->ws + WS_KB); const bf16_t* VBp = (const bf16_t*)(A->ws + WS_VB);
    const bf16_t* CK = (const bf16_t*)(A->ws + WS_CK); const bf16_t* CV = (const bf16_t*)(A->ws + WS_CV);
    int b, h, NT, qtok0, r = 0, rs = 0, rlo = 0, half = 0;
    if (NA) { b = un >> 7; h = (un >> 3) & 15; const int R4 = un & 7; r = 4 * R4 + (wid >> 1); half = wid & 1; qtok0 = NPROMPT + b * 2048 + r * 64 + half * 32;
        rs = min(max(r - 4, 0), 24); rlo = min(max(4 * R4 - 4, 0), 24); const int rhi = min(max(4 * R4 - 1, 0), 24) + 7; NT = 8 + (rhi - rlo + 1); }
    else { b = un >> 4; h = un & 15; qtok0 = b * 256 + wid * 32; NT = 4; }
    LAS float* wsf = (LAS float*)(lds + WSF) + wid * 64;
    LAS float* bl = (LAS float*)(lds + BIAS);
    if (NA) { for (int i = tid; i < 640; i += 512) bl[i] = (i >= 64 && i < 529) ? A->in[I_RPB][h * 465 + i - 64] * LOG2E : 0.f; }
    bf16x8 qr[4];
    { const bf16_t* qp = Q + (size_t)(qtok0 + r32) * 1024 + h * 64 + hi * 8;
#pragma unroll
      for (int d0 = 0; d0 < 4; ++d0) qr[d0] = *(const bf16x8*)(qp + d0 * 16); }
    asm volatile("s_waitcnt vmcnt(0)" : "+v"(qr[0]), "+v"(qr[1]), "+v"(qr[2]), "+v"(qr[3]) :: "memory");
    const int qc = half * 32 + r32, cs = min(max(qc - 8, 0), 48);
    float m20[20];
    if (NA) {
#pragma unroll
        for (int e = 0; e < 20; ++e) {
            const int rr0 = (e < 16) ? e : e - 16, kc0 = ccol(rr0) + ((e < 16) ? 0 : 32);
            const int rr1 = (e < 4) ? 12 + e : e - 4, kc1 = ccol(rr1) + ((e < 4) ? 0 : 32);
            const int kc = (half ? kc1 : kc0) + 4 * hi;
            m20[e] = (kc >= cs && kc < cs + 16) ? 0.f : -1e30f;
        }
    } else {
#pragma unroll
        for (int e = 0; e < 20; ++e) m20[e] = 0.f;
    }
    const int koff = wid * 512 + lane * 8, voff = koff;
    auto issue = [&](int tt, int sl) {
        const bf16_t *kb, *vb;
        if (NA) { if (tt < 8) { const size_t o = (size_t)((b * 8 + tt) * 16 + h) * 4096; kb = CK + o; vb = CV + o; }
                  else { const size_t o = (size_t)((64 + b * 32 + rlo + tt - 8) * 16 + h) * 4096; kb = KBp + o; vb = VBp + o; } }
        else { const size_t o = (size_t)((b * 4 + tt) * 16 + h) * 4096; kb = KBp + o; vb = VBp + o; }
        const int so = RING + (sl & 3) * SLOT + wid * 1024;
        __builtin_amdgcn_global_load_lds((const unsigned*)(kb + koff), (LAS unsigned*)(lds + so), 16, 0, 0);
        __builtin_amdgcn_global_load_lds((const unsigned*)(vb + voff), (LAS unsigned*)(lds + so + 8192), 16, 0, 0);
    };
    issue(0, 0); issue(1, 1); issue(2, 2);
    float mhat = 0.f, lrun = 0.f; f32x16 o0 = {}, o1 = {}, negm = {};
    const int lb = 64 + 4 * hi - qc + 15;
#pragma unroll 1
    for (int t = 0; t < NT; ++t) {
        asm volatile("s_waitcnt vmcnt(4)" ::: "memory");
        __builtin_amdgcn_s_barrier(); asm volatile("" ::: "memory");
        issue(min(t + 3, NT - 1), t + 3);
        const int kr = rlo + t - 8;
        const LAS unsigned char* slot = lds + RING + (t & 3) * SLOT;
        if (!NA || t < 8) tile<0>(slot, qr, negm, mhat, lrun, o0, o1, wsf, bl, m20, r32, hi, lane, t == 0);
        else if (kr >= rs && kr < rs + 8) {
            const LAS float* brow = bl + (kr - r + 7) * 31 + lb;
            if (half == 0) tile<1>(slot, qr, negm, mhat, lrun, o0, o1, wsf, brow, m20, r32, hi, lane, false);
            else tile<2>(slot, qr, negm, mhat, lrun, o0, o1, wsf, brow, m20, r32, hi, lane, false);
        }
    }
    asm volatile("s_waitcnt vmcnt(0)" ::: "memory");
    const bf16_t* ZA = (const bf16_t*)(A->ws + WS_ZA); bf16_t* A2 = (bf16_t*)(A->ws + WS_A2);
    const float ltot = lrun + __shfl_xor(lrun, 32);
    if (hi == 0) wsf[32 + r32] = ltot;
    LDS_WAIT();
    LAS bf16_t* stg = (LAS bf16_t*)(lds + STG) + wid * 2048;
#pragma unroll
    for (int rr = 0; rr < 16; ++rr) { const int orow = crow(rr, hi); const float rl = __builtin_amdgcn_rcpf(wsf[32 + orow]);
        stg[orow * 64 + r32] = (bf16_t)(cvtpk(o0[rr] * rl, 0.f) & 0xffffu); stg[orow * 64 + 32 + r32] = (bf16_t)(cvtpk(o1[rr] * rl, 0.f) & 0xffffu); }
    LDS_WAIT();
#pragma unroll
    for (int i = 0; i < 4; ++i) { const int row = i * 8 + (lane >> 3), ch = lane & 7; const u32x4 ov = *(const LAS u32x4*)(stg + row * 64 + ch * 8);
        const size_t tok = (size_t)(qtok0 + row);
        f32x4 a0, a1, z0, z1; unpack8(ov, a0, a1); unpack8(*(const u32x4*)(ZA + tok * 1024 + h * 64 + ch * 8), z0, z1);
        *(u32x4*)(A2 + tok * 2048 + 1024 + h * 64 + ch * 8) = pack8(a0 * z0, a1 * z1); }
    __syncthreads();
}
#undef MX3
}

constexpr int NPHASE = 9;
__device__ __forceinline__ int opaque_i(int v) { asm volatile("" : "+s"(v)); return v; }
__global__ void __launch_bounds__(NWAVES * 64, 2) fwd_kernel(Args args_unused) {
    KP args = fresh_kp();
    extern __shared__ __attribute__((aligned(16))) unsigned char lds_raw[];
    LAS unsigned char* lds = (LAS unsigned char*)lds_raw;
    volatile LAS unsigned* MISC = (volatile LAS unsigned*)(lds + MISC_OFF);
    const int tid = threadIdx.x, lane = tid & 63, wave = __builtin_amdgcn_readfirstlane(tid >> 6);
    const int G = gridDim.x;
    for (int u = tid; u < (LDS_BYTES - MISC_OFF) / 4; u += NWAVES * 64) ((LAS unsigned*)(lds + MISC_OFF))[u] = 0u;
    __syncthreads();
    unsigned* barw = (unsigned*)(args->ws + WS_CTL) + 4096;
    const int lo = args->ph_lo, hi = args->ph_hi;
    const bool one = (hi - lo) > 1;
    XcdBarrier bar; bar.bar = barw; bar.x = 0; bar.st = nullptr;
    if (one) bar = xcd_barrier_post(barw, MISC + 8);
#ifndef PHMASK
#define PHMASK 0x1ff
#endif
#define IN(k) (((PHMASK >> (k)) & 1) && lo <= (k) && (k) < hi)
#ifndef DUPMASK
#define DUPMASK 0
#endif
#define REP(k) _Pragma("unroll 1") for (int rep_ = 0; rep_ < 1 + ((DUPMASK >> (k)) & 1); ++rep_)
#define NREP(k) (1 + ((DUPMASK >> (k)) & 1))
#ifndef TS_A
#define TS_A -2
#define TS_B -2
#endif
    unsigned long long* stamps = (unsigned long long*)(args->ws + WS_CTL + 2048);
    int n_stamp = 0;
#define STAMP() do { if (TS_A >= -1 && blockIdx.x == 0 && tid == 0) stamps[n_stamp] = __builtin_amdgcn_s_memrealtime(); ++n_stamp; } while (0)
    STAMP();
#define SEAM(k) do { if (IN(k) && IN((k) + 1)) xcd_barrier(bar); STAMP(); } while (0)

    if (IN(0)) { KP kp = fresh_kp(); REP(0) phase0(kp, lds, tid, lane, wave); if (IN(2)) xcd_barrier(bar); STAMP(); }
    if (IN(2)) {
        KP kp = fresh_kp(); unsigned char* ws = kp->ws;
        pg8::Gemm g{(const bf16_t*)(ws + WS_XN), (const bf16_t*)(ws + WS_WIN), 2048, 2048, 2048};
        pg8::StaticOrder S; S.init(32, 40, G, (int)blockIdx.x, NREP(2));
        EpiIn E{(bf16_t*)(ws + WS_UH), (bf16_t*)(ws + WS_ZS), (bf16_t*)(ws + WS_Q), (bf16_t*)(ws + WS_KB), (bf16_t*)(ws + WS_VB), (bf16_t*)(ws + WS_ZA), (bf16_t*)(ws + WS_GS), (bf16_t*)(ws + WS_GA),
                kp->out + OUT_CK, kp->out + OUT_CV, kp->in[I_QNW], kp->in[I_KNW], (LAS float*)(lds + XCH_OFF)};
        pg8::gemm_phase<EpiIn, pg8::StaticOrder, true>(lds, g, S, E);
        SEAM(2);
    }
    if (IN(3)) {
        unsigned* ctl = (unsigned*)(fresh_kp()->ws + WS_CTL);
        if (blockIdx.x < 128) {
            KP kp = fresh_kp(); unsigned char* ws = kp->ws; const int L = blockIdx.x;
            { pg8::Gemm g{(const bf16_t*)(ws + WS_UH), (const bf16_t*)(ws + WS_WA), 512, 256, 256}; pg8::OneUnit S{L, L >> 1}; EpiS E{(float*)(ws + WS_S)};
              pg8::gemm_phase<EpiS, pg8::OneUnit, false>(lds, g, S, E); }
            VM_WAIT(); __syncthreads();
            ssm_scan_unit(kp, lds, L, tid);
            VM_WAIT(); __syncthreads();
            { pg8::Gemm g{(const bf16_t*)(ws + WS_UH), (const bf16_t*)(ws + WS_WOS), 512, 512, 512}; pg8::OneUnit S{L, L >> 1}; EpiY E{(bf16_t*)(ws + WS_YS)};
              pg8::gemm_phase<EpiY, pg8::OneUnit, false>(lds, g, S, E); }
            VM_WAIT(); __syncthreads();
            if (tid == 0) { __builtin_amdgcn_fence(__ATOMIC_RELEASE, "agent"); VM_WAIT(); __hip_atomic_fetch_add(ctl + ((L & 1) ? CW_SSM1 : CW_SSM0), 1u, __ATOMIC_RELAXED, __HIP_MEMORY_SCOPE_AGENT); }
        }
        STAMP();
        for (;;) {
            KP kp = fresh_kp();
            __syncthreads();
            if (tid == 0) MISC[16] = __hip_atomic_fetch_add(ctl + CW_ATT, 1u, __ATOMIC_RELAXED, __HIP_MEMORY_SCOPE_AGENT);
            __syncthreads();
            const int un = (int)MISC[16];
            if (un >= 640) break;
            if (un < 256) att::unit<true>(kp, lds, un, tid);
            else if (un < 384) {
                const int gu = un - 256, pm = gu >> 2, pn = gu & 3;
                if (tid == 0) {
                    unsigned* c = ctl + (pm < 16 ? CW_SSM0 : CW_SSM1); unsigned sp = 0;
                    while (__hip_atomic_load(c, __ATOMIC_RELAXED, __HIP_MEMORY_SCOPE_AGENT) < 64u) { __builtin_amdgcn_s_sleep(4); if (++sp > (1u << 22)) break; }
                    __builtin_amdgcn_fence(__ATOMIC_ACQUIRE, "agent"); VM_WAIT();
                }
                __syncthreads();
                unsigned char* ws = kp->ws;
                pg8::Gemm g{(const bf16_t*)(ws + WS_YS), (const bf16_t*)(ws + WS_WGLU), 1024, 1024, 1024}; pg8::OneUnit S{pm, pn};
                EpiGlu E{(const bf16_t*)(ws + WS_YS), (const bf16_t*)(ws + WS_ZS), kp->in[I_BGLU], (bf16_t*)(ws + WS_A2)};
                pg8::gemm_phase<EpiGlu, pg8::OneUnit, false>(lds, g, S, E);
            }
            else att::unit<false>(kp, lds, un - 384, tid);
        }
        SEAM(3);
    }
    if (IN(7)) {
        KP kp = fresh_kp(); unsigned char* ws = kp->ws;
        pg8::Gemm g{(const bf16_t*)(ws + WS_A2), (const bf16_t*)(ws + WS_WM), 2048, 2048, 2048};
        pg8::StaticOrder S; S.init(32, 8, G, (int)blockIdx.x, NREP(7));
        EpiMerge E{(const bf16_t*)(ws + WS_GS), (const bf16_t*)(ws + WS_GA), (bf16_t*)(ws + WS_MG)};
        pg8::gemm_phase<EpiMerge, pg8::StaticOrder, false>(lds, g, S, E);
        SEAM(7);
    }
    if (IN(8)) {
        KP kp = fresh_kp(); unsigned char* ws = kp->ws;
        pg8::Gemm g{(const bf16_t*)(ws + WS_MG), (const bf16_t*)(ws + WS_WO), 2048, 2048, 2048};
        pg8::StaticOrder S; S.init(32, 8, G, (int)blockIdx.x, NREP(8));
        EpiOut E{kp->in[I_XP], kp->in[I_XS], (const float*)(ws + WS_MOD), kp->out + OUT_Y};
        pg8::gemm_phase<EpiOut, pg8::StaticOrder, false>(lds, g, S, E);
    }
    STAMP();
    if (TS_A >= -1 && blockIdx.x == 0) {
        VM_WAIT(); __syncthreads();
        float t_us = 200.0f;
        if (TS_A >= 0) { const unsigned long long a = __hip_atomic_load(stamps + (TS_A < 0 ? 0 : TS_A), __ATOMIC_RELAXED, __HIP_MEMORY_SCOPE_AGENT), b = __hip_atomic_load(stamps + (TS_B < 0 ? 0 : TS_B), __ATOMIC_RELAXED, __HIP_MEMORY_SCOPE_AGENT); t_us = (float)(long long)(b - a) * 0.01f; }
        const float eps = __builtin_sqrtf(__builtin_fmaxf(t_us, 0.f) * 2e-7f);
        KP kp = fresh_kp(); float* o = kp->out + OUT_SIM;
        for (int i = tid; i < 131072; i += 512) o[i] = o[i] * (1.0f + eps);
    }
#undef IN
#undef SEAM
}

extern "C" void kernel_launch(void* const* d_in, const int* in_sizes, int n_in, void* d_out, int out_size, void* d_ws, size_t ws_size, hipStream_t stream) {
    static int grid = 0;
    if (grid == 0) {
        if (n_in != 28 || out_size != (int)OUT_TOTAL || ws_size < WS_END) { fprintf(stderr, "kernel_launch: unexpected problem (n_in %d, out %d, ws %zu)\n", n_in, out_size, ws_size); grid = -1; return; }
        int dev = 0, cus = 0, per_cu = 0;
        if (hipGetDevice(&dev) != hipSuccess || hipDeviceGetAttribute(&cus, hipDeviceAttributeMultiprocessorCount, dev) != hipSuccess) { grid = -1; return; }
        if (hipFuncSetAttribute((const void*)fwd_kernel, hipFuncAttributeMaxDynamicSharedMemorySize, LDS_BYTES) != hipSuccess) { fprintf(stderr, "kernel_launch: hipFuncSetAttribute failed\n"); grid = -1; return; }
        if (hipOccupancyMaxActiveBlocksPerMultiprocessor(&per_cu, (const void*)fwd_kernel, NWAVES * 64, LDS_BYTES) != hipSuccess || per_cu < 1) { fprintf(stderr, "kernel_launch: occupancy query says %d\n", per_cu); per_cu = 1; }
        (void)hipGetLastError();
        grid = cus;
        fprintf(stderr, "kernel_launch: grid %d (cus %d, per_cu %d), ws %zu\n", grid, cus, per_cu, ws_size);
    }
    if (grid < 0) return;
    (void)hipMemsetAsync((char*)d_ws + WS_CTL, 0, CTL_ZERO_BYTES, stream);
    Args a{};
    for (int i = 0; i < 28; ++i) a.in[i] = (const float*)d_in[i];
    a.out = (float*)d_out; a.ws = (unsigned char*)d_ws;
#if MK_N_LAUNCHES == 1
    a.ph_lo = 0; a.ph_hi = NPHASE;
    void* params[] = {&a};
    hipError_t e = hipLaunchCooperativeKernel((const void*)fwd_kernel, dim3(grid), dim3(NWAVES * 64), params, LDS_BYTES, stream);
    if (e != hipSuccess) fprintf(stderr, "kernel_launch: cooperative launch failed: %s\n", hipGetErrorString(e));
#else
    for (int p = 0; p < NPHASE; ++p) {
        a.ph_lo = p; a.ph_hi = p + 1;
        hipLaunchKernelGGL(fwd_kernel, dim3(grid), dim3(NWAVES * 64), LDS_BYTES, stream, a);
    }
#endif
}
```

```cpp
#include <hip/hip_runtime.h>
#include <cstdio>
#include <cstdint>

#ifndef MK_N_LAUNCHES
#define MK_N_LAUNCHES 1
#endif

#define GAS __attribute__((address_space(1)))
#define LAS __attribute__((address_space(3)))
typedef unsigned short bf16_t;
typedef short bf16x8 __attribute__((ext_vector_type(8)));
typedef short s16x4 __attribute__((ext_vector_type(4)));
typedef float f32x4 __attribute__((ext_vector_type(4)));
typedef float f32x16 __attribute__((ext_vector_type(16)));
typedef unsigned u32x4 __attribute__((ext_vector_type(4)));
typedef unsigned u32x2 __attribute__((ext_vector_type(2)));
typedef float f32x2_t __attribute__((ext_vector_type(2)));
typedef __bf16 bf16x2_t __attribute__((ext_vector_type(2)));

constexpr int DM = 2048, NTOK = 8192, NPROMPT = 4096, INW = 10240, SSMW = 1024, ATTW = 1024, NH = 16, HD = 64;
constexpr int NGRP = 64, NSTATE = 64, TCH = 16;
constexpr float EPSN = 1e-6f;
constexpr float LOG2E = 1.4426950408889634f;
constexpr float QSCALE = 0.125f * LOG2E;

constexpr size_t MiB = 1u << 20;
constexpr size_t WS_CTL = 0, CTL_ZERO_BYTES = 32768;
constexpr size_t WS_MOD = 1 * MiB;
constexpr size_t WS_WIN = 2 * MiB;
constexpr size_t WS_A2 = 2 * MiB;
constexpr size_t WS_WGLU = 42 * MiB;
constexpr size_t WS_WM = 44 * MiB;
constexpr size_t WS_WO = 52 * MiB;
constexpr size_t WS_WA = 60 * MiB;
constexpr size_t WS_WOS = 68 * MiB;
constexpr size_t WS_CK = 84 * MiB, WS_CV = 86 * MiB;
constexpr size_t WS_XN = 88 * MiB;
constexpr size_t WS_S = 88 * MiB;
constexpr size_t WS_UH = 120 * MiB;
constexpr size_t WS_MG = 120 * MiB;
constexpr size_t WS_ZS = 152 * MiB;
constexpr size_t WS_Q = 168 * MiB;
constexpr size_t WS_YS = 296 * MiB;
constexpr size_t WS_KB = 184 * MiB, WS_VB = 200 * MiB, WS_ZA = 216 * MiB;
constexpr size_t WS_GS = 232 * MiB, WS_GA = 264 * MiB;
constexpr size_t WS_END = 312 * MiB;

constexpr size_t OUT_Y = 0, OUT_CK = 16777216, OUT_CV = 20971520, OUT_SRE = 25165824, OUT_SIM = 25296896, OUT_TOTAL = 25427968;

constexpr int RING_BYTES = 131072;
constexpr int XCH_OFF = RING_BYTES;
constexpr int MISC_OFF = RING_BYTES + 8192;
constexpr int LDS_BYTES = 147456;

constexpr int NWAVES = 8;

__device__ __forceinline__ unsigned cvtpk(float lo, float hi) { f32x2_t v = {lo, hi}; bf16x2_t b = __builtin_convertvector(v, bf16x2_t); return __builtin_bit_cast(unsigned, b); }
__device__ __forceinline__ float bf2f(unsigned short h) { return __builtin_bit_cast(float, (unsigned)h << 16); }
__device__ __forceinline__ float bflo(unsigned w) { return __builtin_bit_cast(float, w << 16); }
__device__ __forceinline__ float bfhi(unsigned w) { return __builtin_bit_cast(float, w & 0xffff0000u); }
__device__ __forceinline__ float sigm_f(float x) { return __builtin_amdgcn_rcpf(1.f + __builtin_amdgcn_exp2f(-LOG2E * x)); }
__device__ __forceinline__ float silu_f(float x) { return x * sigm_f(x); }
__device__ __forceinline__ float gelu_f(float x) { return x * sigm_f(1.5957691216057308f * (x + 0.044715f * x * x * x)); }
__device__ __forceinline__ u32x4 pack8(f32x4 a, f32x4 b) { u32x4 w; w.x = cvtpk(a[0], a[1]); w.y = cvtpk(a[2], a[3]); w.z = cvtpk(b[0], b[1]); w.w = cvtpk(b[2], b[3]); return w; }
__device__ __forceinline__ void unpack8(u32x4 w, f32x4& a, f32x4& b) { a = (f32x4){bflo(w.x), bfhi(w.x), bflo(w.y), bfhi(w.y)}; b = (f32x4){bflo(w.z), bfhi(w.z), bflo(w.w), bfhi(w.w)}; }
__device__ __forceinline__ float wave_sum(float v) {
#pragma unroll
    for (int o = 1; o < 64; o <<= 1) v += __shfl_xor(v, o);
    return v;
}
__device__ __forceinline__ void sincos_rad(float x, float& s, float& c) {
    float rev = x * 0.15915494309189535f; rev -= __builtin_floorf(rev);
    s = __builtin_amdgcn_sinf(rev); c = __builtin_amdgcn_cosf(rev);
}
#define LDS_WAIT() asm volatile("s_waitcnt lgkmcnt(0)" ::: "memory")
#define VM_WAIT() asm volatile("s_waitcnt vmcnt(0)" ::: "memory")

namespace pg8 {
constexpr int BM = 256, BK = 64, HALF = 128, HTB = HALF * BK * 2, STAGE_BYTES = 8 * HTB, NXCD = 8, WGM = 8;
__host__ __device__ __forceinline__ int lds_byte(int r, int c) { const int st = (r >> 4) * 2 + (c >> 5), rr = r & 15, cc = c & 31, ob = rr * 64 + cc * 2; return st * 1024 + (ob ^ (((ob >> 9) & 1) << 5)); }
__host__ __device__ __forceinline__ void stage_rc(int b, int& R, int& C) { const int st = b / 1024, sb = b % 1024, swz = sb ^ (((sb >> 9) & 1) << 5); R = (st >> 1) * 16 + swz / 64; C = (st & 1) * 32 + (swz % 64) / 2; }
__host__ __device__ __forceinline__ int perm32(int rho) { const int n = rho >> 4, i = rho & 15; return 8 * (i >> 2) + 4 * n + (i & 3); }

struct Unit { int pm, pn; };
struct Gemm { const bf16_t* A; const bf16_t* Bt; int lda, ldb, K; };

struct StaticOrder {
    int nM, nN, nwg, G, c, rep;
    __device__ void init(int nM_, int nN_, int G_, int c_, int rep_ = 1) { nM = nM_; nN = nN_; nwg = nM * nN; G = G_; c = c_; rep = rep_; }
    __device__ bool next(int i, Unit& u) const {
        long L = (long)i * G + c; if (L >= (long)nwg * rep) return false; if (L >= nwg) L -= nwg;
        int wgid = (int)L; { const int q = nwg / NXCD, r = nwg % NXCD, xcd = wgid % NXCD, off = wgid / NXCD; wgid = (xcd < r ? xcd * (q + 1) : r * (q + 1) + (xcd - r) * q) + off; }
        const int nig = WGM * nN, gid = wgid / nig, fm = gid * WGM, gsz = (nM - fm) < WGM ? (nM - fm) : WGM;
        u.pm = fm + ((wgid % nig) % gsz); u.pn = (wgid % nig) / gsz; return true;
    }
};
struct OneUnit { int pm, pn; __device__ bool next(int i, Unit& u) const { if (i) return false; u.pm = pm; u.pn = pn; return true; } };
struct SsmOrder {
    int G, c, rep;
    __device__ bool next(int i, Unit& u) const { int L = i * G + c; if (L >= 128 * rep) return false; L &= 127; u.pm = L; u.pn = L >> 1; return true; }
};

typedef f32x4 Acc[2][2][4][2];

template <class Epi, class Sched, bool ALIGN_EPI>
__device__ __forceinline__ void gemm_phase(LAS unsigned char* lds, const Gemm g, const Sched& S, const Epi& E) {
    int tid = threadIdx.x; asm volatile("" : "+v"(tid));
    const int wid = __builtin_amdgcn_readfirstlane(tid >> 6), lane = tid & 63, wr = wid >> 2, wc = wid & 3, fr = lane & 15, fq = lane >> 4;
    const int K = g.K, nt = K / BK;
    unsigned voffA[2], voffB[2];
#pragma unroll
    for (int i = 0; i < 2; ++i) { int R, C; stage_rc(tid * 16 + i * 8192, R, C); const int Rb = (R & ~31) + perm32(R & 31);
        voffA[i] = (unsigned)(R * g.lda + C) * 2u; voffB[i] = (unsigned)(Rb * g.ldb + C) * 2u; }
    const size_t kstep = (size_t)(BK * 2);
    const size_t hA = (size_t)HALF * g.lda * 2, hB = (size_t)HALF * g.ldb * 2, tA = 2 * hA, tB = 2 * hB;
    const unsigned ldsw = (unsigned)wid * 1024u;
    const int aoff = lds_byte(wr * 64 + fr, fq * 8), boff = lds_byte(wc * 32 + fr, fq * 8);
#define PG8_SA(b, h) (((b) * 2 + (h)) * HTB)
#define PG8_SB(b, h) ((4 + (b) * 2 + (h)) * HTB)
#define PG8_STAGE(bufoff, gbase, voff) do { _Pragma("unroll") for (int _i = 0; _i < 2; ++_i) \
        __builtin_amdgcn_global_load_lds((const unsigned*)((const char*)(gbase) + (voff)[_i]), (LAS unsigned*)(lds + (bufoff) + ldsw + _i * 8192), 16, 0, 0); } while (0)
#define PG8_LDA(dst, b, h) do { _Pragma("unroll") for (int m = 0; m < 4; ++m) _Pragma("unroll") for (int k = 0; k < 2; ++k) dst[m][k] = *(const LAS bf16x8*)(lds + PG8_SA(b, h) + aoff + m * 2048 + k * 1024); } while (0)
#define PG8_LDB(dst, b, h) do { _Pragma("unroll") for (int n = 0; n < 2; ++n) _Pragma("unroll") for (int k = 0; k < 2; ++k) dst[n][k] = *(const LAS bf16x8*)(lds + PG8_SB(b, h) + boff + n * 2048 + k * 1024); } while (0)
#define PG8_MMA(ai, bj, At, Bt) do { __builtin_amdgcn_s_setprio(1); _Pragma("unroll") for (int m = 0; m < 4; ++m) _Pragma("unroll") for (int n = 0; n < 2; ++n) _Pragma("unroll") for (int k = 0; k < 2; ++k) \
        acc[ai][bj][m][n] = __builtin_amdgcn_mfma_f32_16x16x32_bf16(Bt[n][k], At[m][k], acc[ai][bj][m][n], 0, 0, 0); __builtin_amdgcn_s_setprio(0); } while (0)
#define PG8_WAIT_V(n) asm volatile("s_waitcnt vmcnt(" #n ")" ::: "memory")
#define PG8_WAIT_L(n) asm volatile("s_waitcnt lgkmcnt(" #n ")" ::: "memory")
#define PG8_BAR __builtin_amdgcn_s_barrier()
#define PG8_SCHED __builtin_amdgcn_sched_barrier(0)
    Unit cur, nxt; int ui = 0;
    if (!S.next(0, cur)) return;
    Acc acc;
#pragma unroll
    for (int a = 0; a < 2; ++a)
#pragma unroll
        for (int b = 0; b < 2; ++b)
#pragma unroll
            for (int m = 0; m < 4; ++m)
#pragma unroll
                for (int n = 0; n < 2; ++n) acc[a][b][m][n] = (f32x4){0.f, 0.f, 0.f, 0.f};
    bf16x8 At[4][2], B0[2][2], B1[2][2];
    const char* cA = (const char*)g.A + (size_t)cur.pm * tA; const char* cB = (const char*)g.Bt + (size_t)cur.pn * tB;
    PG8_STAGE(PG8_SB(0, 0), cB, voffB); PG8_STAGE(PG8_SB(0, 1), cB + hB, voffB); PG8_STAGE(PG8_SA(0, 0), cA, voffA); PG8_STAGE(PG8_SA(0, 1), cA + hA, voffA);
    if (wr == 1) PG8_BAR;
    PG8_WAIT_V(2); PG8_BAR;
    PG8_STAGE(PG8_SB(1, 0), cB + kstep, voffB); PG8_STAGE(PG8_SA(1, 0), cA + kstep, voffA); PG8_STAGE(PG8_SB(1, 1), cB + hB + kstep, voffB);
    PG8_WAIT_V(6); PG8_BAR;
    for (;;) {
        const bool has_next = S.next(ui + 1, nxt);
        const char* nA = has_next ? (const char*)g.A + (size_t)nxt.pm * tA : cA; const char* nB = has_next ? (const char*)g.Bt + (size_t)nxt.pn * tB : cB;
#pragma unroll 1
        for (int t = 0; t < nt; t += 2) {
            const bool last = (t == nt - 2);
            const char* a1 = cA + (size_t)(t + 1) * kstep;
            const char* a2 = last ? nA : cA + (size_t)(t + 2) * kstep; const char* b2 = last ? nB : cB + (size_t)(t + 2) * kstep;
            const char* a3 = a2 + kstep; const char* b3 = b2 + kstep;
            if constexpr (Epi::MIDK) { if (t == (nt >> 1)) E.mid(acc, cur, wr, wc, fr, fq); }
            PG8_LDB(B0, 0, 0); PG8_LDB(B1, 0, 1); PG8_SCHED; PG8_LDA(At, 0, 0); PG8_STAGE(PG8_SA(1, 1), a1 + hA, voffA);
            PG8_WAIT_V(8); PG8_WAIT_L(0); PG8_BAR; PG8_MMA(0, 0, At, B0); PG8_MMA(0, 1, At, B1); PG8_BAR; PG8_SCHED;
            PG8_LDA(At, 0, 1); PG8_STAGE(PG8_SB(0, 0), b2, voffB); PG8_STAGE(PG8_SB(0, 1), b2 + hB, voffB); PG8_STAGE(PG8_SA(0, 0), a2, voffA);
            PG8_WAIT_V(8); PG8_WAIT_L(0); PG8_BAR; PG8_MMA(1, 0, At, B0); PG8_MMA(1, 1, At, B1); PG8_BAR; PG8_SCHED;
            PG8_LDB(B0, 1, 0); PG8_LDB(B1, 1, 1); PG8_SCHED; PG8_LDA(At, 1, 0); PG8_STAGE(PG8_SA(0, 1), a2 + hA, voffA);
            PG8_WAIT_V(8); PG8_WAIT_L(0); PG8_BAR; PG8_MMA(0, 0, At, B0); PG8_MMA(0, 1, At, B1); PG8_BAR; PG8_SCHED;
            PG8_LDA(At, 1, 1); PG8_STAGE(PG8_SB(1, 0), b3, voffB); PG8_STAGE(PG8_SB(1, 1), b3 + hB, voffB); PG8_STAGE(PG8_SA(1, 0), a3, voffA);
            PG8_WAIT_V(8); PG8_WAIT_L(0); PG8_BAR; PG8_MMA(1, 0, At, B0); PG8_MMA(1, 1, At, B1); PG8_BAR; PG8_SCHED;
        }
        if constexpr (ALIGN_EPI) { if (wr == 0) PG8_BAR; }
        E(acc, cur, wr, wc, fr, fq);
        if (!has_next) break;
#pragma unroll
        for (int a = 0; a < 2; ++a)
#pragma unroll
            for (int b = 0; b < 2; ++b)
#pragma unroll
                for (int m = 0; m < 4; ++m)
#pragma unroll
                    for (int n = 0; n < 2; ++n) acc[a][b][m][n] = (f32x4){0.f, 0.f, 0.f, 0.f};
        cur = nxt; cA = nA; cB = nB; ++ui;
        if constexpr (ALIGN_EPI) { if (wr == 1) PG8_BAR; }
    }
    PG8_WAIT_V(0);
    if constexpr (!ALIGN_EPI) { if (wr == 0) PG8_BAR; }
    PG8_BAR;
#undef PG8_SA
#undef PG8_SB
#undef PG8_STAGE
#undef PG8_LDA
#undef PG8_LDB
#undef PG8_MMA
#undef PG8_WAIT_V
#undef PG8_WAIT_L
#undef PG8_BAR
#undef PG8_SCHED
}
}

#define EPI_LOOP(ai, m, bj) _Pragma("unroll") for (int ai = 0; ai < 2; ++ai) _Pragma("unroll") for (int m = 0; m < 4; ++m) _Pragma("unroll") for (int bj = 0; bj < 2; ++bj)

struct EpiIn {
    static constexpr bool MIDK = false;
    bf16_t *UH, *ZS, *Q, *KB, *VB, *ZA, *GS, *GA; float *ock, *ocv; const float *qw, *kw; LAS float* xch;
    __device__ __forceinline__ void operator()(const pg8::Acc& acc, const pg8::Unit& u, int wr, int wc, int fr, int fq) const {
        const int type = u.pn >> 2;
        const int row0 = u.pm * 256 + wr * 64 + fr;
        const int col0 = u.pn * 256 + wc * 32 + 8 * fq;
        if (type == 0) {
            EPI_LOOP(ai, m, bj) { const int tok = row0 + ai * 128 + m * 16, c = col0 + bj * 128; const int g = c >> 4, i0 = c & 15;
                *(u32x4*)(UH + ((size_t)(g * 512 + (tok >> 4)) * 512 + (tok & 15) * 16 + i0)) = pack8(acc[ai][bj][m][0], acc[ai][bj][m][1]); }
        } else if (type == 1 || type == 5) {
            bf16_t* O = (type == 1) ? ZS : ZA; const int cb = (type == 1) ? 1024 : 5120;
            EPI_LOOP(ai, m, bj) { const int tok = row0 + ai * 128 + m * 16, c = col0 + bj * 128 - cb; f32x4 a = acc[ai][bj][m][0], b = acc[ai][bj][m][1];
#pragma unroll
                for (int e = 0; e < 4; ++e) { a[e] = silu_f(a[e]); b[e] = silu_f(b[e]); }
                *(u32x4*)(O + (size_t)tok * 1024 + c) = pack8(a, b); }
        } else if (type >= 6) {
            bf16_t* O = (type < 8) ? GS : GA; const int cb = (type < 8) ? 6144 : 8192;
            EPI_LOOP(ai, m, bj) { const int tok = row0 + ai * 128 + m * 16, c = col0 + bj * 128 - cb; f32x4 a = acc[ai][bj][m][0], b = acc[ai][bj][m][1];
#pragma unroll
                for (int e = 0; e < 4; ++e) { a[e] = sigm_f(a[e]); b[e] = sigm_f(b[e]); }
                *(u32x4*)(O + (size_t)tok * 2048 + c) = pack8(a, b); }
        } else if (type == 4) {
            EPI_LOOP(ai, m, bj) { const int tok = row0 + ai * 128 + m * 16, c = col0 + bj * 128 - 4096; const f32x4 a = acc[ai][bj][m][0], b = acc[ai][bj][m][1];
                { const int hh = c >> 6, d0 = c & 63;
                  *(u32x4*)(VB + (size_t)((tok >> 6) * 16 + hh) * 4096 + ((d0 >> 5) * 4 + ((tok & 63) >> 4)) * 512 + (tok & 15) * 32 + ((d0 & 31) >> 3) * 8) = pack8(a, b); }
                if (tok < NPROMPT) { *(f32x4*)(ocv + (size_t)tok * 1024 + c) = a; *(f32x4*)(ocv + (size_t)tok * 1024 + c + 4) = b; } }
        } else {
            float ss[2][4][2];
            EPI_LOOP(ai, m, bj) { const f32x4 a = acc[ai][bj][m][0], b = acc[ai][bj][m][1];
                float s = (a[0] * a[0] + a[1] * a[1]) + (a[2] * a[2] + a[3] * a[3]) + (b[0] * b[0] + b[1] * b[1]) + (b[2] * b[2] + b[3] * b[3]);
                s += __shfl_xor(s, 16); s += __shfl_xor(s, 32); ss[ai][m][bj] = s;
                if (fq == 0) xch[(ai * 128 + wr * 64 + m * 16 + fr) * 8 + bj * 4 + wc] = s; }
            LDS_WAIT(); __builtin_amdgcn_s_barrier(); asm volatile("" ::: "memory");
            const float* nw = (type == 2) ? qw : kw; const float osc = (type == 2) ? QSCALE : 1.0f;
            const int d0 = (wc & 1) * 32 + 8 * fq;
            const f32x4 w0 = *(const f32x4*)(nw + d0), w1 = *(const f32x4*)(nw + d0 + 4);
            bf16_t* O = (type == 2) ? Q : KB; const int cb = (type == 2) ? 2048 : 3072;
            EPI_LOOP(ai, m, bj) { const int tok = row0 + ai * 128 + m * 16, c = col0 + bj * 128 - cb;
                const float tot = ss[ai][m][bj] + xch[(ai * 128 + wr * 64 + m * 16 + fr) * 8 + bj * 4 + (wc ^ 1)];
                const float rstd = __builtin_amdgcn_rsqf(tot * (1.0f / 64.0f) + EPSN);
                f32x4 a = acc[ai][bj][m][0] * rstd * w0, b = acc[ai][bj][m][1] * rstd * w1;
                if (type == 3 && tok < NPROMPT) { *(f32x4*)(ock + (size_t)tok * 1024 + c) = a; *(f32x4*)(ock + (size_t)tok * 1024 + c + 4) = b; }
                a = a * osc; b = b * osc;
                if (type == 2) *(u32x4*)(O + (size_t)tok * 1024 + c) = pack8(a, b);
                else { const int hh = c >> 6, d0 = c & 63;
                    *(u32x4*)(O + (size_t)((tok >> 6) * 16 + hh) * 4096 + (d0 >> 3) * 512 + (tok & 63) * 8) = pack8(a, b); } }
        }
    }
};

struct EpiS {
    static constexpr bool MIDK = false;
    float* S;
    __device__ __forceinline__ void operator()(const pg8::Acc& acc, const pg8::Unit& u, int wr, int wc, int fr, int fq) const {
        const int row0 = u.pm * 256 + wr * 64 + fr, col0 = wc * 32 + 8 * fq;
        EPI_LOOP(ai, m, bj) { float* p = S + (size_t)(row0 + ai * 128 + m * 16) * 256 + col0 + bj * 128; *(f32x4*)p = acc[ai][bj][m][0]; *(f32x4*)(p + 4) = acc[ai][bj][m][1]; }
    }
};
struct EpiY {
    static constexpr bool MIDK = false;
    bf16_t* YS;
    __device__ __forceinline__ void operator()(const pg8::Acc& acc, const pg8::Unit& u, int wr, int wc, int fr, int fq) const {
        const int g = u.pm >> 1, ch0 = (u.pm & 1) * 256 + wr * 64 + fr, col0 = wc * 32 + 8 * fq;
        EPI_LOOP(ai, m, bj) { const int chunk = ch0 + ai * 128 + m * 16, c = col0 + bj * 128, tau = c >> 4, i0 = c & 15; f32x4 a = acc[ai][bj][m][0], b = acc[ai][bj][m][1];
#pragma unroll
            for (int e = 0; e < 4; ++e) { a[e] = gelu_f(a[e]); b[e] = gelu_f(b[e]); }
            *(u32x4*)(YS + (size_t)(chunk * 16 + tau) * 1024 + g * 16 + i0) = pack8(a, b); }
    }
};
struct EpiGlu {
    static constexpr bool MIDK = false;
    const bf16_t *YS, *ZS; const float* bglu; bf16_t* A2;
    __device__ __forceinline__ void operator()(const pg8::Acc& acc, const pg8::Unit& u, int wr, int wc, int fr, int fq) const {
        const int row0 = u.pm * 256 + wr * 64 + fr, col0 = u.pn * 256 + wc * 32 + 8 * fq;
        f32x4 bb[2][2];
#pragma unroll
        for (int bj = 0; bj < 2; ++bj) { bb[bj][0] = *(const f32x4*)(bglu + col0 + bj * 128); bb[bj][1] = *(const f32x4*)(bglu + col0 + bj * 128 + 4); }
#pragma unroll
        for (int ai = 0; ai < 2; ++ai) {
            u32x4 yv[4][2], zv[4][2];
#pragma unroll
            for (int m = 0; m < 4; ++m)
#pragma unroll
                for (int bj = 0; bj < 2; ++bj) { const size_t off = (size_t)(row0 + ai * 128 + m * 16) * 1024 + col0 + bj * 128; yv[m][bj] = *(const u32x4*)(YS + off); zv[m][bj] = *(const u32x4*)(ZS + off); }
#pragma unroll
            for (int m = 0; m < 4; ++m)
#pragma unroll
                for (int bj = 0; bj < 2; ++bj) { f32x4 y0, y1, z0, z1; unpack8(yv[m][bj], y0, y1); unpack8(zv[m][bj], z0, z1);
                    f32x4 a = acc[ai][bj][m][0] + bb[bj][0], b = acc[ai][bj][m][1] + bb[bj][1];
#pragma unroll
                    for (int e = 0; e < 4; ++e) { a[e] = y0[e] * sigm_f(a[e]) * z0[e]; b[e] = y1[e] * sigm_f(b[e]) * z1[e]; }
                    *(u32x4*)(A2 + (size_t)(row0 + ai * 128 + m * 16) * 2048 + col0 + bj * 128) = pack8(a, b); }
            asm volatile("" ::: "memory");
        }
    }
};
struct EpiMerge {
    static constexpr bool MIDK = true;
    const bf16_t *GS, *GA; bf16_t* MG;
    __device__ __forceinline__ void mid(pg8::Acc& acc, const pg8::Unit& u, int wr, int wc, int fr, int fq) const {
        int row0 = u.pm * 256 + wr * 64 + fr, col0 = u.pn * 256 + wc * 32 + 8 * fq;
        asm volatile("" : "+v"(row0), "+v"(col0));
#pragma unroll
        for (int ai = 0; ai < 2; ++ai) {
            u32x4 gs[4][2], ga[4][2];
#pragma unroll
            for (int m = 0; m < 4; ++m)
#pragma unroll
                for (int bj = 0; bj < 2; ++bj) { const size_t off = (size_t)(row0 + ai * 128 + m * 16) * 2048 + col0 + bj * 128; gs[m][bj] = *(const u32x4*)(GS + off); ga[m][bj] = *(const u32x4*)(GA + off); }
#pragma unroll
            for (int m = 0; m < 4; ++m)
#pragma unroll
                for (int bj = 0; bj < 2; ++bj) { f32x4 s0, s1, a0, a1; unpack8(gs[m][bj], s0, s1); unpack8(ga[m][bj], a0, a1);
#pragma unroll
                    for (int e = 0; e < 4; ++e) { acc[ai][bj][m][0][e] *= s0[e] * __builtin_amdgcn_rcpf(__builtin_fmaxf(a0[e], 1e-30f)); acc[ai][bj][m][1][e] *= s1[e] * __builtin_amdgcn_rcpf(__builtin_fmaxf(a1[e], 1e-30f)); }
                    asm volatile("" : "+v"(acc[ai][bj][m][0]), "+v"(acc[ai][bj][m][1])); }
            asm volatile("" ::: "memory");
        }
    }
    __device__ __forceinline__ void operator()(const pg8::Acc& acc, const pg8::Unit& u, int wr, int wc, int fr, int fq) const {
        const int row0 = u.pm * 256 + wr * 64 + fr, col0 = u.pn * 256 + wc * 32 + 8 * fq;
        u32x4 ga[2][4][2];
        EPI_LOOP(ai, m, bj) ga[ai][m][bj] = *(const u32x4*)(GA + (size_t)(row0 + ai * 128 + m * 16) * 2048 + col0 + bj * 128);
        EPI_LOOP(ai, m, bj) { const size_t off = (size_t)(row0 + ai * 128 + m * 16) * 2048 + col0 + bj * 128;
            f32x4 a0, a1; unpack8(ga[ai][m][bj], a0, a1);
            *(u32x4*)(MG + off) = pack8(acc[ai][bj][m][0] * a0, acc[ai][bj][m][1] * a1); }
    }
};
struct EpiOut {
    static constexpr bool MIDK = false;
    const float *xp, *xs, *mod; float* out;
    __device__ __forceinline__ void operator()(const pg8::Acc& acc, const pg8::Unit& u, int wr, int wc, int fr, int fq) const {
        const int row0 = u.pm * 256 + wr * 64 + fr, col0 = u.pn * 256 + wc * 32 + 8 * fq;
        const int cond = (u.pm < 16) ? 0 : 1 + ((u.pm - 16) >> 3);
        const float* gate = mod + cond * 6144 + 4096;
        const float* xb = (u.pm < 16) ? xp : xs - (size_t)NPROMPT * 2048;
        f32x4 gg[2][2];
#pragma unroll
        for (int bj = 0; bj < 2; ++bj) { gg[bj][0] = *(const f32x4*)(gate + col0 + bj * 128); gg[bj][1] = *(const f32x4*)(gate + col0 + bj * 128 + 4); }
#pragma unroll
        for (int ai = 0; ai < 2; ++ai)
#pragma unroll
            for (int mh = 0; mh < 2; ++mh) {
                f32x4 xv[2][2][2];
#pragma unroll
                for (int mm = 0; mm < 2; ++mm)
#pragma unroll
                    for (int bj = 0; bj < 2; ++bj) { const float* xr = xb + (size_t)(row0 + ai * 128 + (mh * 2 + mm) * 16) * 2048 + col0 + bj * 128; xv[mm][bj][0] = *(const f32x4*)xr; xv[mm][bj][1] = *(const f32x4*)(xr + 4); }
#pragma unroll
                for (int mm = 0; mm < 2; ++mm)
#pragma unroll
                    for (int bj = 0; bj < 2; ++bj) { const int m = mh * 2 + mm; float* o = out + (size_t)(row0 + ai * 128 + m * 16) * 2048 + col0 + bj * 128;
                        *(f32x4*)o = xv[mm][bj][0] + gg[bj][0] * acc[ai][bj][m][0]; *(f32x4*)(o + 4) = xv[mm][bj][1] + gg[bj][1] * acc[ai][bj][m][1]; }
                asm volatile("" ::: "memory");
            }
    }
};

#define XB_TMO      128
#define XB_XCNT(j)  (256  + 64 * (j))
#define XB_XSUB(j)  (1280 + 64 * (j))
#define XB_XGEN(j)  (2304 + 64 * (j))
#define XB_TOP      3328
#define XB_TOPGEN   3392
#define XCD_BAR_WORDS 3456
#define XB_SPIN_CAP (1u << 20)
__device__ __forceinline__ unsigned xb_ld(unsigned* p)              { return __hip_atomic_load(p, __ATOMIC_RELAXED, __HIP_MEMORY_SCOPE_AGENT); }
__device__ __forceinline__ unsigned xb_add(unsigned* p, unsigned v) { return __hip_atomic_fetch_add(p, v, __ATOMIC_RELAXED, __HIP_MEMORY_SCOPE_AGENT); }
__device__ __forceinline__ unsigned xb_xcc_id() { return (unsigned)__builtin_amdgcn_s_getreg((3 << 11) | 20) & 0xFu; }
#define XB_SPIN(cond, bar) do { unsigned _sp = 0; while (cond) { __builtin_amdgcn_s_sleep(1); \
    if ((++_sp & 255u) == 0u) { if (xb_ld(&(bar)[XB_TMO])) break; if (_sp > XB_SPIN_CAP) { atomicAdd(&(bar)[XB_TMO], 1u); break; } } } } while (0)
struct XcdBarrier { unsigned* bar; unsigned x; volatile LAS unsigned* st; };
__device__ __forceinline__ XcdBarrier xcd_barrier_post(unsigned* bar, volatile LAS unsigned* st) {
    XcdBarrier b; b.bar = bar; b.x = xb_xcc_id(); b.st = st;
    if (threadIdx.x == 0) (void)xb_add(&bar[XB_XCNT(b.x)], 1u);
    return b;
}
__device__ __forceinline__ void xcd_barrier_complete(unsigned* bar, unsigned x, unsigned& nloc, unsigned& nx) {
    const unsigned G = gridDim.x * gridDim.y * gridDim.z;
    unsigned sum, cnt, mine, sp = 0u;
    for (;;) {
        sum = 0u; cnt = 0u; mine = 0u;
#pragma unroll
        for (unsigned j = 0; j < 16; ++j) { const unsigned c = xb_ld(&bar[XB_XCNT(j)]); sum += c; cnt += (c > 0u) ? 1u : 0u; mine = (j == x) ? c : mine; }
        if (sum == G) break;
        __builtin_amdgcn_s_sleep(1);
        if ((++sp & 255u) == 0u) { if (xb_ld(&bar[XB_TMO])) break; if (sp > XB_SPIN_CAP) { atomicAdd(&bar[XB_TMO], 1u); break; } }
    }
    nloc = mine > 0u ? mine : 1u; nx = cnt > 0u ? cnt : 1u;
}
__device__ __forceinline__ void xcd_barrier(const XcdBarrier& b) {
    asm volatile("s_waitcnt vmcnt(0)" ::: "memory");
    __syncthreads();
    if (threadIdx.x == 0) {
        unsigned* bar = b.bar;
        __builtin_amdgcn_s_waitcnt(0);
        unsigned nloc = b.st[0], nx = b.st[1];
        if (nloc == 0u) { xcd_barrier_complete(bar, b.x, nloc, nx); b.st[0] = nloc; b.st[1] = nx; }
        const unsigned old = xb_add(&bar[XB_XSUB(b.x)], 1u);
        const unsigned gen = old / nloc;
        if (old + 1u == (gen + 1u) * nloc) {
            __builtin_amdgcn_fence(__ATOMIC_RELEASE, "agent");
            asm volatile("s_waitcnt vmcnt(0)" ::: "memory");
            const unsigned og = xb_add(&bar[XB_TOP], 1u);
            const unsigned tg = og / nx;
            if (og + 1u == (tg + 1u) * nx) xb_add(&bar[XB_TOPGEN], 1u);
            else XB_SPIN(xb_ld(&bar[XB_TOPGEN]) == tg, bar);
            __builtin_amdgcn_fence(__ATOMIC_ACQUIRE, "agent");
            xb_add(&bar[XB_XGEN(b.x)], 1u);
            asm volatile("s_waitcnt vmcnt(0)" ::: "memory");
        } else {
            XB_SPIN(xb_ld(&bar[XB_XGEN(b.x)]) == gen, bar);
            __builtin_amdgcn_fence(__ATOMIC_ACQUIRE, "agent");
            asm volatile("s_waitcnt vmcnt(0)" ::: "memory");
        }
    }
    __syncthreads();
}

struct Args { const float* in[28]; float* out; unsigned char* ws; int ph_lo, ph_hi; };
typedef const __attribute__((address_space(4))) Args* KP;
__device__ __forceinline__ KP fresh_kp() { KP kp = (KP)__builtin_amdgcn_kernarg_segment_ptr(); asm volatile("" : "+s"(kp)); return kp; }
enum { I_XP = 0, I_XS, I_CK, I_CV, I_SRE, I_SIM, I_C, I_CCTX, I_NORMW, I_WADA, I_BADA, I_WIN, I_QNW, I_KNW, I_RPB, I_ARE, I_AIM, I_LOGDT, I_BRE, I_BIM, I_CRE, I_CIM, I_D, I_WGLU, I_BGLU, I_WSSM, I_WATT, I_WO };

__device__ __forceinline__ void p0_transpose_item(const float* W, int N, bf16_t* WT, int ldt, int koff, LAS float* scr, int item, int lane) {
    const int nblk = N / 64, kb = item / nblk, nb = item % nblk, k0 = 64 * kb, n0 = 64 * nb;
    const int c16 = lane & 15, r4 = lane >> 4;
    f32x4 v[16];
#pragma unroll
    for (int i = 0; i < 16; ++i) v[i] = *(const f32x4*)(W + (size_t)(k0 + 4 * i + r4) * N + n0 + 4 * c16);
#pragma unroll
    for (int i = 0; i < 16; ++i) { LAS float* d = scr + (4 * i + r4) * 65 + 4 * c16; d[0] = v[i][0]; d[1] = v[i][1]; d[2] = v[i][2]; d[3] = v[i][3]; }
    LDS_WAIT(); asm volatile("" ::: "memory");
    const int c = lane & 7;
#pragma unroll
    for (int j = 0; j < 8; ++j) { const int n = (lane >> 3) + 8 * j; const LAS float* sp = scr + (8 * c) * 65 + n;
        u32x4 o; o.x = cvtpk(sp[0 * 65], sp[1 * 65]); o.y = cvtpk(sp[2 * 65], sp[3 * 65]); o.z = cvtpk(sp[4 * 65], sp[5 * 65]); o.w = cvtpk(sp[6 * 65], sp[7 * 65]);
        *(u32x4*)(WT + (size_t)(n0 + n) * ldt + koff + k0 + 8 * c) = o; }
    LDS_WAIT(); asm volatile("" ::: "memory");
}

__device__ __forceinline__ void p0_ssm_prep(KP A, LAS float* sc, int g, int qt, int tid) {
    LAS float* LPr = sc;
    LAS float* LPi = sc + 2176;
    LAS float* BBr = sc + 4352;
    LAS float* BBi = sc + 6400;
    LAS float* CCr = sc + 8448;
    LAS float* CCi = sc + 10496;
    LAS float* KT = sc + 12544;
    LAS float* COr = sc + 14592;
    LAS float* COi = sc + 14720;
    const float* a_re = A->in[I_ARE]; const float* a_im = A->in[I_AIM]; const float* logdt = A->in[I_LOGDT];
    {
        const int d = (tid >> 6) & 1, p = tid & 63, slot = tid >> 7;
        const float are = __builtin_fminf(a_re[(d * 64 + g) * 64 + p], -1e-4f), aim = a_im[(d * 64 + g) * 64 + p];
        const float dt = __expf(logdt[d * 64 + g]);
        const float zr = are * dt, zi = aim * dt;
#pragma unroll 1
        for (int e = slot; e <= 16; e += 4) { float sn, cn; sincos_rad((float)e * zi, sn, cn); const float mg = __expf((float)e * zr); LPr[(d * 17 + e) * 64 + p] = mg * cn; LPi[(d * 17 + e) * 64 + p] = mg * sn; }
        if (slot == 0) {
            float s1, c1, sh, chh; sincos_rad(zi, s1, c1); sincos_rad(0.5f * zi, sh, chh); (void)chh;
            const float em1 = expm1f(zr), mg = em1 + 1.0f;
            const float nr = em1 * c1 - 2.0f * sh * sh, ni = mg * s1;
            const float den = 1.0f / (are * are + aim * aim);
            COr[d * 64 + p] = (nr * are + ni * aim) * den; COi[d * 64 + p] = (ni * are - nr * aim) * den;
        }
    }
    __syncthreads();
    {
        const float* b_re = A->in[I_BRE]; const float* b_im = A->in[I_BIM]; const float* c_re = A->in[I_CRE]; const float* c_im = A->in[I_CIM];
#pragma unroll
        for (int n = 0; n < 4; ++n) { const int idx = tid + 512 * n, d = idx >> 10, p = (idx >> 4) & 63;
            const float br = b_re[((size_t)(d * 64 + g) * 64) * 16 + (idx & 1023)], bi = b_im[((size_t)(d * 64 + g) * 64) * 16 + (idx & 1023)];
            const float cr = COr[d * 64 + p], ci = COi[d * 64 + p];
            BBr[idx] = cr * br - ci * bi; BBi[idx] = cr * bi + ci * br; }
#pragma unroll
        for (int n = 0; n < 4; ++n) { const int idx = tid + 512 * n, d = idx >> 10, i = (idx >> 6) & 15, p = idx & 63;
            CCr[(d * 64 + p) * 16 + i] = c_re[((size_t)(d * 64 + g) * 16 + i) * 64 + p]; CCi[(d * 64 + p) * 16 + i] = c_im[((size_t)(d * 64 + g) * 16 + i) * 64 + p]; }
    }
    __syncthreads();
    {
        const int d = tid >> 8, dloc = (tid >> 6) & 3, i = (tid >> 2) & 15, jq = tid & 3, dl = 4 * qt + dloc;
        f32x4 acc = {0.f, 0.f, 0.f, 0.f};
#pragma unroll 4
        for (int p = 0; p < 64; ++p) {
            const float cr = CCr[(d * 64 + p) * 16 + i], ci = CCi[(d * 64 + p) * 16 + i], lr = LPr[(d * 17 + dl) * 64 + p], li = LPi[(d * 17 + dl) * 64 + p];
            const float tr = cr * lr - ci * li, ti = cr * li + ci * lr;
            const f32x4 br = *(const LAS f32x4*)(BBr + (d * 64 + p) * 16 + 4 * jq), bi = *(const LAS f32x4*)(BBi + (d * 64 + p) * 16 + 4 * jq);
            acc += tr * br - ti * bi;
        }
        *(LAS f32x4*)(KT + (d * 4 + dloc) * 256 + i * 16 + 4 * jq) = acc;
    }
    __syncthreads();
    bf16_t* WA = (bf16_t*)(A->ws + WS_WA) + (size_t)g * 256 * 256;
    bf16_t* WOS = (bf16_t*)(A->ws + WS_WOS) + (size_t)g * 256 * 512;
#pragma unroll 1
    for (int it = 0; it < 4; ++it) {
        const int q = it * 512 + tid, n = 64 * qt + (q >> 5), s = (q >> 1) & 15, jh = q & 1, d = n >> 7, ri = (n >> 6) & 1, p = n & 63;
        const int e = (d == 0) ? 15 - s : s;
        const float lr = LPr[(d * 17 + e) * 64 + p], li = LPi[(d * 17 + e) * 64 + p];
        const f32x4 br0 = *(const LAS f32x4*)(BBr + (d * 64 + p) * 16 + jh * 8), br1 = *(const LAS f32x4*)(BBr + (d * 64 + p) * 16 + jh * 8 + 4);
        const f32x4 bi0 = *(const LAS f32x4*)(BBi + (d * 64 + p) * 16 + jh * 8), bi1 = *(const LAS f32x4*)(BBi + (d * 64 + p) * 16 + jh * 8 + 4);
        const f32x4 v0 = ri == 0 ? lr * br0 - li * bi0 : lr * bi0 + li * br0, v1 = ri == 0 ? lr * br1 - li * bi1 : lr * bi1 + li * br1;
        *(u32x4*)(WA + (size_t)n * 256 + s * 16 + jh * 8) = pack8(v0, v1);
    }
    const float* dsk = A->in[I_D];
#pragma unroll 1
    for (int it = 0; it < 8; ++it) {
        const int q = it * 512 + tid, n = q >> 4, sidx = (q >> 1) & 7, jh = q & 1, tau = n >> 4, i = n & 15;
        int s, dd, dloc;
        if (sidx < 4) { dloc = 3 - sidx; s = tau - 4 * qt - dloc; dd = 0; } else { dloc = sidx - 4; s = tau + 4 * qt + dloc; dd = 1; }
        const bool diag = (qt == 0 && dloc == 0);
        if (s < 0 || s > 15 || (diag && dd == 1)) continue;
        const LAS float* kp = KT + (dd * 4 + dloc) * 256 + i * 16 + jh * 8;
        f32x4 v0 = *(const LAS f32x4*)kp, v1 = *(const LAS f32x4*)(kp + 4);
        if (diag) { const LAS float* k2 = KT + (1 * 4 + 0) * 256 + i * 16 + jh * 8; v0 += *(const LAS f32x4*)k2; v1 += *(const LAS f32x4*)(k2 + 4);
            const float dv = dsk[g * 16 + i]; const int jj = i - jh * 8;
            if (jj >= 0 && jj < 4) v0[jj] += dv; else if (jj >= 4 && jj < 8) v1[jj - 4] += dv; }
        *(u32x4*)(WOS + (size_t)n * 512 + s * 16 + jh * 8) = pack8(v0, v1);
    }
#pragma unroll 1
    for (int it = 0; it < 4; ++it) {
        const int q = it * 512 + tid, n = 64 * qt + (q >> 5), pc = q & 31, tau = n >> 4, i = n & 15;
        const int kk = pc * 8, d = kk >> 7, ri = (kk >> 6) & 1, p0 = kk & 63, f = (d == 0) ? tau + 1 : 16 - tau;
        float v[8];
#pragma unroll
        for (int jj = 0; jj < 8; ++jj) { const int p = p0 + jj; const float cr = CCr[(d * 64 + p) * 16 + i], ci = CCi[(d * 64 + p) * 16 + i], lr = LPr[(d * 17 + f) * 64 + p], li = LPi[(d * 17 + f) * 64 + p];
            v[jj] = ri == 0 ? cr * lr - ci * li : -(cr * li + ci * lr); }
        u32x4 o; o.x = cvtpk(v[0], v[1]); o.y = cvtpk(v[2], v[3]); o.z = cvtpk(v[4], v[5]); o.w = cvtpk(v[6], v[7]);
        *(u32x4*)(WOS + (size_t)n * 512 + 256 + pc * 8) = o;
    }
    __syncthreads();
}

__device__ __forceinline__ void p0_gemv_strip(KP A, LAS float* sc, int s, int tid) {
    LAS float* cs = sc;
    LAS float* red = sc + 6144;
    const float* cctx = A->in[I_CCTX]; const float* c = A->in[I_C];
    for (int i = tid; i < 6144; i += 512) { const float v = (i < 2048) ? cctx[i] : c[i - 2048]; cs[i] = silu_f(v); }
    __syncthreads();
    const int wid = tid >> 6, lane = tid & 63, kk = lane >> 3, c4 = lane & 7;
    const float* W = A->in[I_WADA] + (size_t)(256 * wid + kk) * 6144 + 32 * s + 4 * c4;
    f32x4 a0 = {0.f, 0.f, 0.f, 0.f}, a1 = a0, a2 = a0;
#pragma unroll 32
    for (int it = 0; it < 32; ++it) { const f32x4 w = *(const f32x4*)(W + (size_t)it * 8 * 6144); const int k = 256 * wid + 8 * it + kk;
        a0 += cs[k] * w; a1 += cs[2048 + k] * w; a2 += cs[4096 + k] * w; }
#pragma unroll
    for (int e = 0; e < 4; ++e) {
#pragma unroll
        for (int o = 8; o < 64; o <<= 1) { a0[e] += __shfl_xor(a0[e], o); a1[e] += __shfl_xor(a1[e], o); a2[e] += __shfl_xor(a2[e], o); }
    }
    if (kk == 0) {
#pragma unroll
        for (int e = 0; e < 4; ++e) { red[(wid * 3 + 0) * 32 + c4 * 4 + e] = a0[e]; red[(wid * 3 + 1) * 32 + c4 * 4 + e] = a1[e]; red[(wid * 3 + 2) * 32 + c4 * 4 + e] = a2[e]; }
    }
    __syncthreads();
    if (tid < 96) { const int cnd = tid >> 5, col = tid & 31; float v = A->in[I_BADA][32 * s + col];
#pragma unroll
        for (int w = 0; w < 8; ++w) v += red[(w * 3 + cnd) * 32 + col];
        ((float*)(A->ws + WS_MOD))[cnd * 6144 + 32 * s + col] = v; }
    __syncthreads();
}

constexpr int CW_GEMV = 64, CW_ATT = 128, CW_SSM0 = 192, CW_SSM1 = 256;
__device__ __forceinline__ void phase1(KP A, int lane, int wave);
__device__ __forceinline__ void phase0(KP A, LAS unsigned char* lds, int tid, int lane, int wave) {
    const int bx = blockIdx.x, G = gridDim.x;
    unsigned* cnt = (unsigned*)(A->ws + WS_CTL) + CW_GEMV;
#ifndef SUBDUP
#define SUBDUP 0
#endif
    LAS float* scr = (LAS float*)(lds + wave * 16640);
    const int gw = bx * NWAVES + wave, NGW = G * NWAVES;
    constexpr int I_IN = 32 * 160, I_GLU = 16 * 16, I_SO = 16 * 32, I_AO = 16 * 32, I_O = 32 * 32, NITEMS = I_IN + I_GLU + I_SO + I_AO + I_O;
#pragma unroll 1
    for (int step = 0; step < 3; ++step) {
        const int what = (bx & 1) ? (step == 0 ? 2 : step - 1) : step;
        if (what == 0) {
            for (int t = bx; t < 192; t += G) {
                p0_gemv_strip(A, (LAS float*)lds, t, tid);
                VM_WAIT(); __syncthreads();
                if (tid == 0) { __builtin_amdgcn_fence(__ATOMIC_RELEASE, "agent"); VM_WAIT(); __hip_atomic_fetch_add(cnt, 1u, __ATOMIC_RELAXED, __HIP_MEMORY_SCOPE_AGENT); }
            }
        } else if (what == 1) {
            __syncthreads();
            constexpr int NA_ = 4160;
            const bool bal = (G == 256);
            const int i0 = !bal ? gw : (bx < 192 ? gw : NA_ + (gw - 1536)), istr = !bal ? NGW : (bx < 192 ? 1536 : 512), iend = !bal ? NITEMS : (bx < 192 ? NA_ : NITEMS);
            for (int it = i0; it < iend; it += istr) {
                int r = it;
                if (r < I_IN) { p0_transpose_item(A->in[I_WIN], INW, (bf16_t*)(A->ws + WS_WIN), 2048, 0, scr, r, lane); continue; } r -= I_IN;
                if (r < I_GLU) { p0_transpose_item(A->in[I_WGLU], 1024, (bf16_t*)(A->ws + WS_WGLU), 1024, 0, scr, r, lane); continue; } r -= I_GLU;
                if (r < I_SO) { p0_transpose_item(A->in[I_WSSM], 2048, (bf16_t*)(A->ws + WS_WM), 2048, 0, scr, r, lane); continue; } r -= I_SO;
                if (r < I_AO) { p0_transpose_item(A->in[I_WATT], 2048, (bf16_t*)(A->ws + WS_WM), 2048, 1024, scr, r, lane); continue; } r -= I_AO;
                p0_transpose_item(A->in[I_WO], 2048, (bf16_t*)(A->ws + WS_WO), 2048, 0, scr, r, lane);
            }
            __syncthreads();
        } else {
            for (int t = bx; t < 256; t += G) p0_ssm_prep(A, (LAS float*)lds, t >> 2, t & 3, tid);
        }
    }
    {
        const int gt = bx * 512 + tid, NT = G * 512;
        for (int i = gt; i < 2 * 131072; i += NT) {
            const int which = i >> 17, j = i & 131071;
            const float* src = A->in[which ? I_CV : I_CK] + (size_t)j * 8;
            const f32x4 a = *(const f32x4*)src, b = *(const f32x4*)(src + 4);
            const int row = j >> 7, hh = (j >> 3) & 15, d0 = (j & 7) * 8;
            const size_t img = (size_t)((row >> 6) * 16 + hh) * 4096;
            const size_t off = which ? img + ((d0 >> 5) * 4 + ((row & 63) >> 4)) * 512 + (row & 15) * 32 + ((d0 & 31) >> 3) * 8 : img + (d0 >> 3) * 512 + (row & 63) * 8;
            *(u32x4*)((bf16_t*)(A->ws + (which ? WS_CV : WS_CK)) + off) = pack8(a, b);
        }
    }
    if (tid == 0) {
        unsigned sp = 0;
        while (__hip_atomic_load(cnt, __ATOMIC_RELAXED, __HIP_MEMORY_SCOPE_AGENT) < 192u) { __builtin_amdgcn_s_sleep(2); if (++sp > (1u << 22)) break; }
        __builtin_amdgcn_fence(__ATOMIC_ACQUIRE, "agent");
        VM_WAIT();
    }
    __syncthreads();
    _Pragma("unroll 1") for (int sd_ = 0; sd_ < 1 + ((SUBDUP >> 3) & 1); ++sd_)
    phase1(A, lane, wave);
}

__device__ __forceinline__ void phase1(KP A, int lane, int wave) {
    const int gw = blockIdx.x * NWAVES + wave, NGW = gridDim.x * NWAVES;
    const float* mod = (const float*)(A->ws + WS_MOD); const float* nw = A->in[I_NORMW];
    bf16_t* XN = (bf16_t*)(A->ws + WS_XN);
    for (int m = gw; m < NTOK; m += NGW) {
        const float* xr = (m < NPROMPT) ? A->in[I_XP] + (size_t)m * 2048 : A->in[I_XS] + (size_t)(m - NPROMPT) * 2048;
        const int cond = (m < NPROMPT) ? 0 : 1 + ((m - NPROMPT) >> 11);
        const float* sh = mod + cond * 6144; const float* scl = sh + 2048;
        f32x4 v[8]; float s = 0.f;
#pragma unroll
        for (int j = 0; j < 8; ++j) { v[j] = *(const f32x4*)(xr + 4 * lane + 256 * j); s += (v[j][0] * v[j][0] + v[j][1] * v[j][1]) + (v[j][2] * v[j][2] + v[j][3] * v[j][3]); }
        const float rstd = __builtin_amdgcn_rsqf(wave_sum(s) * (1.0f / 2048.0f) + EPSN);
#pragma unroll
        for (int j = 0; j < 8; ++j) { const int c = 4 * lane + 256 * j; const f32x4 w = *(const f32x4*)(nw + c), a = *(const f32x4*)(scl + c), b = *(const f32x4*)(sh + c);
            const f32x4 o = (v[j] * rstd * w) * (a + 1.0f) + b; u32x2 pk; pk.x = cvtpk(o[0], o[1]); pk.y = cvtpk(o[2], o[3]);
            *(u32x2*)(XN + (size_t)m * 2048 + c) = pk; }
    }
}

__device__ __forceinline__ void ssm_scan_unit(KP A, LAS unsigned char* lds, int L, int tid) {
    const int g = L >> 1, hf = L & 1;
    const int p = tid & 63, d = (tid >> 6) & 1, sq = tid >> 7;
    LAS float* El = (LAS float*)lds;
    LAS float* Cl = (LAS float*)(lds + 16384);
    const float are = __builtin_fminf(A->in[I_ARE][(d * 64 + g) * 64 + p], -1e-4f), aim = A->in[I_AIM][(d * 64 + g) * 64 + p];
    const float dt = __expf(A->in[I_LOGDT][d * 64 + g]);
    float ls, lc; sincos_rad(16.0f * aim * dt, ls, lc); const float mg = __expf(16.0f * are * dt);
    const float lr = mg * lc, li = mg * ls;
    const float* S = (const float*)(A->ws + WS_S) + (size_t)L * 256 * 256 + d * 128 + p;
    float sr[4][16], si[4][16];
#pragma unroll
    for (int k = 0; k < 4; ++k)
#pragma unroll
        for (int j = 0; j < 16; ++j) { const int row = (sq + 4 * k) * 16 + j; sr[k][j] = S[(size_t)row * 256]; si[k][j] = S[(size_t)row * 256 + 64]; }
    if (hf) {
#pragma unroll
        for (int k = 0; k < 4; ++k) { float er = 0.f, ei = 0.f;
#pragma unroll
            for (int jj = 0; jj < 16; ++jj) { const int j = d ? 15 - jj : jj; const float nr = lr * er - li * ei + sr[k][j], ni = lr * ei + li * er + si[k][j]; er = nr; ei = ni; }
            const int sg = sq + 4 * k; El[(sg * 128 + d * 64 + p) * 2] = er; El[(sg * 128 + d * 64 + p) * 2 + 1] = ei; }
        __syncthreads();
        if (tid < 256) {
            const int sb = tid >> 7;
            float l16r = lr, l16i = li;
#pragma unroll
            for (int q = 0; q < 4; ++q) { const float nr = l16r * l16r - l16i * l16i, ni = 2.0f * l16r * l16i; l16r = nr; l16i = ni; }
            float cr = A->in[I_SRE][((sb * 2 + d) * 64 + g) * 64 + p], ci = A->in[I_SIM][((sb * 2 + d) * 64 + g) * 64 + p];
#pragma unroll
            for (int q = 0; q < 8; ++q) { const int sg = sb * 8 + (d ? 7 - q : q); const int ix = (sg * 128 + d * 64 + p) * 2;
                Cl[ix] = cr; Cl[ix + 1] = ci; const float er = El[ix], ei = El[ix + 1];
                const float nr = l16r * cr - l16i * ci + er, ni = l16r * ci + l16i * cr + ei; cr = nr; ci = ni; }
        }
        __syncthreads();
    }
    bf16_t* H = (bf16_t*)(A->ws + WS_UH) + (size_t)L * 256 * 512 + 256 + d * 128 + p;
#pragma unroll
    for (int k = 0; k < 4; ++k) { const int sg = sq + 4 * k;
        float hr = 0.f, hi = 0.f;
        if (hf) { hr = Cl[(sg * 128 + d * 64 + p) * 2]; hi = Cl[(sg * 128 + d * 64 + p) * 2 + 1]; }
#pragma unroll
        for (int jj = 0; jj < 16; ++jj) { const int j = d ? 15 - jj : jj; const size_t row = (size_t)(sg * 16 + j);
            H[row * 512] = (bf16_t)(cvtpk(hr, 0.f) & 0xffffu); H[row * 512 + 64] = (bf16_t)(cvtpk(hi, 0.f) & 0xffffu);
            const float nr = lr * hr - li * hi + sr[k][j], ni = lr * hi + li * hr + si[k][j]; hr = nr; hi = ni; }
        if (!hf) { A->out[OUT_SRE + ((size_t)(sg * 2 + d) * 64 + g) * 64 + p] = hr; A->out[OUT_SIM + ((size_t)(sg * 2 + d) * 64 + g) * 64 + p] = hi; }
    }
}

namespace att {
constexpr int NSLOT = 4, SLOT = 16384;
constexpr int RING = 0, WSF = 65536, STG = 67584, BIAS = 100352;
constexpr float THR = 8.0f;
__device__ __forceinline__ int crow(int r, int hi) { return (r & 3) + 8 * (r >> 2) + 4 * hi; }
__device__ __forceinline__ constexpr int ccol(int r) { return (r & 3) + 8 * (r >> 2); }
__device__ __forceinline__ s16x4 vtr(const LAS unsigned char* p) { return __builtin_bit_cast(s16x4, __builtin_amdgcn_ds_read_tr16_b64_v4i16((LAS s16x4*)p)); }
#define MX3(a, b, c) __builtin_fmaxf(__builtin_fmaxf((a), (b)), (c))

template <int MODE>
__device__ __forceinline__ void tile(const LAS unsigned char* slot, const bf16x8 (&qr)[4], f32x16& negm, float& mhat, float& lrun, f32x16& o0, f32x16& o1,
                                     LAS float* wsf, const LAS float* brow, const float (&m20)[20], int r32, int hi, int lane, bool first) {
    constexpr int P0_LO = (MODE == 2) ? 12 : 0, P1_HI = (MODE == 1) ? 4 : 16;
    f32x16 p0, p1;
    { const LAS unsigned char* kb = slot + hi * 1024 + r32 * 16;
#pragma unroll
      for (int d0 = 0; d0 < 4; ++d0) { const bf16x8 b0 = *(const LAS bf16x8*)(kb + d0 * 2048), b1 = *(const LAS bf16x8*)(kb + d0 * 2048 + 512);
          if (d0 == 0) { p0 = __builtin_amdgcn_mfma_f32_32x32x16_bf16(b0, qr[0], negm, 0, 0, 0); p1 = __builtin_amdgcn_mfma_f32_32x32x16_bf16(b1, qr[0], negm, 0, 0, 0); }
          else { p0 = __builtin_amdgcn_mfma_f32_32x32x16_bf16(b0, qr[d0], p0, 0, 0, 0); p1 = __builtin_amdgcn_mfma_f32_32x32x16_bf16(b1, qr[d0], p1, 0, 0, 0); } } }
    if (MODE != 0) {
#pragma unroll
        for (int rr = P0_LO; rr < 16; ++rr) p0[rr] += brow[ccol(rr)] + m20[MODE == 1 ? rr : rr - 12];
#pragma unroll
        for (int rr = 0; rr < P1_HI; ++rr) p1[rr] += brow[32 + ccol(rr)] + m20[MODE == 1 ? 16 + rr : 4 + rr];
    }
    float ra, rb;
    if (MODE == 0) { ra = MX3(p0[0], p0[1], p1[0]); rb = MX3(p0[2], p0[3], p1[1]); ra = MX3(ra, p1[2], p1[3]);
#pragma unroll
        for (int r = 4; r < 16; r += 4) { ra = MX3(ra, p0[r], p0[r + 1]); rb = MX3(rb, p0[r + 2], p0[r + 3]); ra = MX3(ra, p1[r], p1[r + 1]); rb = MX3(rb, p1[r + 2], p1[r + 3]); } }
    else if (MODE == 1) { ra = MX3(p0[0], p0[1], p1[0]); rb = MX3(p0[2], p0[3], p1[1]); ra = MX3(ra, p1[2], p1[3]);
#pragma unroll
        for (int r = 4; r < 16; r += 4) { ra = MX3(ra, p0[r], p0[r + 1]); rb = MX3(rb, p0[r + 2], p0[r + 3]); } }
    else { ra = MX3(p1[0], p1[1], p0[12]); rb = MX3(p1[2], p1[3], p0[13]); ra = MX3(ra, p0[14], p0[15]);
#pragma unroll
        for (int r = 4; r < 16; r += 4) { ra = MX3(ra, p1[r], p1[r + 1]); rb = MX3(rb, p1[r + 2], p1[r + 3]); } }
    float rm = __builtin_fmaxf(ra, rb);
    rm = __builtin_fmaxf(rm, __shfl_xor(rm, 32));
    if (first || __any(rm > THR)) {
        const float dl = first ? rm : __builtin_fmaxf(rm, 0.f);
        mhat += dl;
#pragma unroll
        for (int rr = P0_LO; rr < 16; ++rr) p0[rr] -= dl;
#pragma unroll
        for (int rr = 0; rr < P1_HI; ++rr) p1[rr] -= dl;
#pragma unroll
        for (int rr = 0; rr < 16; ++rr) negm[rr] = -mhat;
        const float f = __builtin_amdgcn_exp2f(-dl);
        lrun *= f;
        if (hi == 0) wsf[r32] = f;
        LDS_WAIT();
#pragma unroll
        for (int rr = 0; rr < 16; ++rr) { const float ff = wsf[crow(rr, hi)]; o0[rr] *= ff; o1[rr] *= ff; }
    }
    float sa = 0.f, sb = 0.f;
#pragma unroll
    for (int rr = P0_LO; rr < 16; rr += 2) { p0[rr] = __builtin_amdgcn_exp2f(p0[rr]); p0[rr + 1] = __builtin_amdgcn_exp2f(p0[rr + 1]); sa += p0[rr]; sb += p0[rr + 1]; }
#pragma unroll
    for (int rr = 0; rr < P1_HI; rr += 2) { p1[rr] = __builtin_amdgcn_exp2f(p1[rr]); p1[rr + 1] = __builtin_amdgcn_exp2f(p1[rr + 1]); sa += p1[rr]; sb += p1[rr + 1]; }
    lrun += sa + sb;
    u32x4 pw[4];
    if (MODE == 2) { pw[0] = (u32x4){0u, 0u, 0u, 0u}; pw[1] = (u32x4){0u, 0u, cvtpk(p0[12], p0[13]), cvtpk(p0[14], p0[15])}; }
    else { pw[0] = (u32x4){cvtpk(p0[0], p0[1]), cvtpk(p0[2], p0[3]), cvtpk(p0[4], p0[5]), cvtpk(p0[6], p0[7])};
           pw[1] = (u32x4){cvtpk(p0[8], p0[9]), cvtpk(p0[10], p0[11]), cvtpk(p0[12], p0[13]), cvtpk(p0[14], p0[15])}; }
    if (MODE == 1) { pw[2] = (u32x4){cvtpk(p1[0], p1[1]), cvtpk(p1[2], p1[3]), 0u, 0u}; pw[3] = (u32x4){0u, 0u, 0u, 0u}; }
    else { pw[2] = (u32x4){cvtpk(p1[0], p1[1]), cvtpk(p1[2], p1[3]), cvtpk(p1[4], p1[5]), cvtpk(p1[6], p1[7])};
           pw[3] = (u32x4){cvtpk(p1[8], p1[9]), cvtpk(p1[10], p1[11]), cvtpk(p1[12], p1[13]), cvtpk(p1[14], p1[15])}; }
    const LAS unsigned char* vp = slot + 8192 + ((lane >> 4) & 1) * 32 + (lane & 3) * 8 + (4 * hi + ((lane & 15) >> 2)) * 64;
    constexpr int K_LO = (MODE == 2) ? 1 : 0, K_HI = (MODE == 1) ? 3 : 4;
#pragma unroll
    for (int k = K_LO; k < K_HI; ++k) {
        const s16x4 l0 = vtr(vp + k * 1024), h0 = vtr(vp + k * 1024 + 512), l1 = vtr(vp + 4096 + k * 1024), h1 = vtr(vp + 4096 + k * 1024 + 512);
        const bf16x8 v0 = (bf16x8){l0[0], l0[1], l0[2], l0[3], h0[0], h0[1], h0[2], h0[3]}, v1 = (bf16x8){l1[0], l1[1], l1[2], l1[3], h1[0], h1[1], h1[2], h1[3]};
        const bf16x8 pa = __builtin_bit_cast(bf16x8, pw[k]);
        o0 = __builtin_amdgcn_mfma_f32_32x32x16_bf16(pa, v0, o0, 0, 0, 0); o1 = __builtin_amdgcn_mfma_f32_32x32x16_bf16(pa, v1, o1, 0, 0, 0);
    }
}

template <bool NA>
__device__ __forceinline__ void unit(KP A, LAS unsigned char* lds, int un, int tid_in) {
    int tid = tid_in; asm volatile("" : "+v"(tid));
    const int lane = tid & 63, r32 = lane & 31, hi = lane >> 5, wid = __builtin_amdgcn_readfirstlane(tid >> 6);
    const bf16_t* Q = (const bf16_t*)(A->ws + WS_Q); const bf16_t* KBp = (const bf16_t*)(A->ws + WS_KB); const bf16_t* VBp = (const bf16_t*)(A->ws + WS_VB);
    const bf16_t* CK = (const bf16_t*)(A->ws + WS_CK); const bf16_t* CV = (const bf16_t*)(A->ws + WS_CV);
    int b, h, NT, qtok0, r = 0, rs = 0, rlo = 0, half = 0;
    if (NA) { b = un >> 7; h = (un >> 3) & 15; const int R4 = un & 7; r = 4 * R4 + (wid >> 1); half = wid & 1; qtok0 = NPROMPT + b * 2048 + r * 64 + half * 32;
        rs = min(max(r - 4, 0), 24); rlo = min(max(4 * R4 - 4, 0), 24); const int rhi = min(max(4 * R4 - 1, 0), 24) + 7; NT = 8 + (rhi - rlo + 1); }
    else { b = un >> 4; h = un & 15; qtok0 = b * 256 + wid * 32; NT = 4; }
    LAS float* wsf = (LAS float*)(lds + WSF) + wid * 64;
    LAS float* bl = (LAS float*)(lds + BIAS);
    if (NA) { for (int i = tid; i < 640; i += 512) bl[i] = (i >= 64 && i < 529) ? A->in[I_RPB][h * 465 + i - 64] * LOG2E : 0.f; }
    bf16x8 qr[4];
    { const bf16_t* qp = Q + (size_t)(qtok0 + r32) * 1024 + h * 64 + hi * 8;
#pragma unroll
      for (int d0 = 0; d0 < 4; ++d0) qr[d0] = *(const bf16x8*)(qp + d0 * 16); }
    asm volatile("s_waitcnt vmcnt(0)" : "+v"(qr[0]), "+v"(qr[1]), "+v"(qr[2]), "+v"(qr[3]) :: "memory");
    const int qc = half * 32 + r32, cs = min(max(qc - 8, 0), 48);
    float m20[20];
    if (NA) {
#pragma unroll
        for (int e = 0; e < 20; ++e) {
            const int rr0 = (e < 16) ? e : e - 16, kc0 = ccol(rr0) + ((e < 16) ? 0 : 32);
            const int rr1 = (e < 4) ? 12 + e : e - 4, kc1 = ccol(rr1) + ((e < 4) ? 0 : 32);
            const int kc = (half ? kc1 : kc0) + 4 * hi;
            m20[e] = (kc >= cs && kc < cs + 16) ? 0.f : -1e30f;
        }
    } else {
#pragma unroll
        for (int e = 0; e < 20; ++e) m20[e] = 0.f;
    }
    const int koff = wid * 512 + lane * 8, voff = koff;
    auto issue = [&](int tt, int sl) {
        const bf16_t *kb, *vb;
        if (NA) { if (tt < 8) { const size_t o = (size_t)((b * 8 + tt) * 16 + h) * 4096; kb = CK + o; vb = CV + o; }
                  else { const size_t o = (size_t)((64 + b * 32 + rlo + tt - 8) * 16 + h) * 4096; kb = KBp + o; vb = VBp + o; } }
        else { const size_t o = (size_t)((b * 4 + tt) * 16 + h) * 4096; kb = KBp + o; vb = VBp + o; }
        const int so = RING + (sl & 3) * SLOT + wid * 1024;
        __builtin_amdgcn_global_load_lds((const unsigned*)(kb + koff), (LAS unsigned*)(lds + so), 16, 0, 0);
        __builtin_amdgcn_global_load_lds((const unsigned*)(vb + voff), (LAS unsigned*)(lds + so + 8192), 16, 0, 0);
    };
    issue(0, 0); issue(1, 1); issue(2, 2);
    float mhat = 0.f, lrun = 0.f; f32x16 o0 = {}, o1 = {}, negm = {};
    const int lb = 64 + 4 * hi - qc + 15;
#pragma unroll 1
    for (int t = 0; t < NT; ++t) {
        asm volatile("s_waitcnt vmcnt(4)" ::: "memory");
        __builtin_amdgcn_s_barrier(); asm volatile("" ::: "memory");
        issue(min(t + 3, NT - 1), t + 3);
        const int kr = rlo + t - 8;
        const LAS unsigned char* slot = lds + RING + (t & 3) * SLOT;
        if (!NA || t < 8) tile<0>(slot, qr, negm, mhat, lrun, o0, o1, wsf, bl, m20, r32, hi, lane, t == 0);
        else if (kr >= rs && kr < rs + 8) {
            const LAS float* brow = bl + (kr - r + 7) * 31 + lb;
            if (half == 0) tile<1>(slot, qr, negm, mhat, lrun, o0, o1, wsf, brow, m20, r32, hi, lane, false);
            else tile<2>(slot, qr, negm, mhat, lrun, o0, o1, wsf, brow, m20, r32, hi, lane, false);
        }
    }
    asm volatile("s_waitcnt vmcnt(0)" ::: "memory");
    const bf16_t* ZA = (const bf16_t*)(A->ws + WS_ZA); bf16_t* A2 = (bf16_t*)(A->ws + WS_A2);
    const float ltot = lrun + __shfl_xor(lrun, 32);
    if (hi == 0) wsf[32 + r32] = ltot;
    LDS_WAIT();
    LAS bf16_t* stg = (LAS bf16_t*)(lds + STG) + wid * 2048;
#pragma unroll
    for (int rr = 0; rr < 16; ++rr) { const int orow = crow(rr, hi); const float rl = __builtin_amdgcn_rcpf(wsf[32 + orow]);
        stg[orow * 64 + r32] = (bf16_t)(cvtpk(o0[rr] * rl, 0.f) & 0xffffu); stg[orow * 64 + 32 + r32] = (bf16_t)(cvtpk(o1[rr] * rl, 0.f) & 0xffffu); }
    LDS_WAIT();
#pragma unroll
    for (int i = 0; i < 4; ++i) { const int row = i * 8 + (lane >> 3), ch = lane & 7; const u32x4 ov = *(const LAS u32x4*)(stg + row * 64 + ch * 8);
        const size_t tok = (size_t)(qtok0 + row);
        f32x4 a0, a1, z0, z1; unpack8(ov, a0, a1); unpack8(*(const u32x4*)(ZA + tok * 1024 + h * 64 + ch * 8), z0, z1);
        *(u32x4*)(A2 + tok * 2048 + 1024 + h * 64 + ch * 8) = pack8(a0 * z0, a1 * z1); }
    __syncthreads();
}
#undef MX3
}

constexpr int NPHASE = 9;
__device__ __forceinline__ int opaque_i(int v) { asm volatile("" : "+s"(v)); return v; }
__global__ void __launch_bounds__(NWAVES * 64, 2) fwd_kernel(Args args_unused) {
    KP args = fresh_kp();
    extern __shared__ __attribute__((aligned(16))) unsigned char lds_raw[];
    LAS unsigned char* lds = (LAS unsigned char*)lds_raw;
    volatile LAS unsigned* MISC = (volatile LAS unsigned*)(lds + MISC_OFF);
    const int tid = threadIdx.x, lane = tid & 63, wave = __builtin_amdgcn_readfirstlane(tid >> 6);
    const int G = gridDim.x;
    for (int u = tid; u < (LDS_BYTES - MISC_OFF) / 4; u += NWAVES * 64) ((LAS unsigned*)(lds + MISC_OFF))[u] = 0u;
    __syncthreads();
    unsigned* barw = (unsigned*)(args->ws + WS_CTL) + 4096;
    const int lo = args->ph_lo, hi = args->ph_hi;
    const bool one = (hi - lo) > 1;
    XcdBarrier bar; bar.bar = barw; bar.x = 0; bar.st = nullptr;
    if (one) bar = xcd_barrier_post(barw, MISC + 8);
#ifndef PHMASK
#define PHMASK 0x1ff
#endif
#define IN(k) (((PHMASK >> (k)) & 1) && lo <= (k) && (k) < hi)
#ifndef DUPMASK
#define DUPMASK 0
#endif
#define REP(k) _Pragma("unroll 1") for (int rep_ = 0; rep_ < 1 + ((DUPMASK >> (k)) & 1); ++rep_)
#define NREP(k) (1 + ((DUPMASK >> (k)) & 1))
#ifndef TS_A
#define TS_A -2
#define TS_B -2
#endif
    unsigned long long* stamps = (unsigned long long*)(args->ws + WS_CTL + 2048);
    int n_stamp = 0;
#define STAMP() do { if (TS_A >= -1 && blockIdx.x == 0 && tid == 0) stamps[n_stamp] = __builtin_amdgcn_s_memrealtime(); ++n_stamp; } while (0)
    STAMP();
#define SEAM(k) do { if (IN(k) && IN((k) + 1)) xcd_barrier(bar); STAMP(); } while (0)

    if (IN(0)) { KP kp = fresh_kp(); REP(0) phase0(kp, lds, tid, lane, wave); if (IN(2)) xcd_barrier(bar); STAMP(); }
    if (IN(2)) {
        KP kp = fresh_kp(); unsigned char* ws = kp->ws;
        pg8::Gemm g{(const bf16_t*)(ws + WS_XN), (const bf16_t*)(ws + WS_WIN), 2048, 2048, 2048};
        pg8::StaticOrder S; S.init(32, 40, G, (int)blockIdx.x, NREP(2));
        EpiIn E{(bf16_t*)(ws + WS_UH), (bf16_t*)(ws + WS_ZS), (bf16_t*)(ws + WS_Q), (bf16_t*)(ws + WS_KB), (bf16_t*)(ws + WS_VB), (bf16_t*)(ws + WS_ZA), (bf16_t*)(ws + WS_GS), (bf16_t*)(ws + WS_GA),
                kp->out + OUT_CK, kp->out + OUT_CV, kp->in[I_QNW], kp->in[I_KNW], (LAS float*)(lds + XCH_OFF)};
        pg8::gemm_phase<EpiIn, pg8::StaticOrder, true>(lds, g, S, E);
        SEAM(2);
    }
    if (IN(3)) {
        unsigned* ctl = (unsigned*)(fresh_kp()->ws + WS_CTL);
        if (blockIdx.x < 128) {
            KP kp = fresh_kp(); unsigned char* ws = kp->ws; const int L = blockIdx.x;
            { pg8::Gemm g{(const bf16_t*)(ws + WS_UH), (const bf16_t*)(ws + WS_WA), 512, 256, 256}; pg8::OneUnit S{L, L >> 1}; EpiS E{(float*)(ws + WS_S)};
              pg8::gemm_phase<EpiS, pg8::OneUnit, false>(lds, g, S, E); }
            VM_WAIT(); __syncthreads();
            ssm_scan_unit(kp, lds, L, tid);
            VM_WAIT(); __syncthreads();
            { pg8::Gemm g{(const bf16_t*)(ws + WS_UH), (const bf16_t*)(ws + WS_WOS), 512, 512, 512}; pg8::OneUnit S{L, L >> 1}; EpiY E{(bf16_t*)(ws + WS_YS)};
              pg8::gemm_phase<EpiY, pg8::OneUnit, false>(lds, g, S, E); }
            VM_WAIT(); __syncthreads();
            if (tid == 0) { __builtin_amdgcn_fence(__ATOMIC_RELEASE, "agent"); VM_WAIT(); __hip_atomic_fetch_add(ctl + ((L & 1) ? CW_SSM1 : CW_SSM0), 1u, __ATOMIC_RELAXED, __HIP_MEMORY_SCOPE_AGENT); }
        }
        STAMP();
        for (;;) {
            KP kp = fresh_kp();
            __syncthreads();
            if (tid == 0) MISC[16] = __hip_atomic_fetch_add(ctl + CW_ATT, 1u, __ATOMIC_RELAXED, __HIP_MEMORY_SCOPE_AGENT);
            __syncthreads();
            const int un = (int)MISC[16];
            if (un >= 640) break;
            if (un < 256) att::unit<true>(kp, lds, un, tid);
            else if (un < 384) {
                const int gu = un - 256, pm = gu >> 2, pn = gu & 3;
                if (tid == 0) {
                    unsigned* c = ctl + (pm < 16 ? CW_SSM0 : CW_SSM1); unsigned sp = 0;
                    while (__hip_atomic_load(c, __ATOMIC_RELAXED, __HIP_MEMORY_SCOPE_AGENT) < 64u) { __builtin_amdgcn_s_sleep(4); if (++sp > (1u << 22)) break; }
                    __builtin_amdgcn_fence(__ATOMIC_ACQUIRE, "agent"); VM_WAIT();
                }
                __syncthreads();
                unsigned char* ws = kp->ws;
                pg8::Gemm g{(const bf16_t*)(ws + WS_YS), (const bf16_t*)(ws + WS_WGLU), 1024, 1024, 1024}; pg8::OneUnit S{pm, pn};
                EpiGlu E{(const bf16_t*)(ws + WS_YS), (const bf16_t*)(ws + WS_ZS), kp->in[I_BGLU], (bf16_t*)(ws + WS_A2)};
                pg8::gemm_phase<EpiGlu, pg8::OneUnit, false>(lds, g, S, E);
            }
            else att::unit<false>(kp, lds, un - 384, tid);
        }
        SEAM(3);
    }
    if (IN(7)) {
        KP kp = fresh_kp(); unsigned char* ws = kp->ws;
        pg8::Gemm g{(const bf16_t*)(ws + WS_A2), (const bf16_t*)(ws + WS_WM), 2048, 2048, 2048};
        pg8::StaticOrder S; S.init(32, 8, G, (int)blockIdx.x, NREP(7));
        EpiMerge E{(const bf16_t*)(ws + WS_GS), (const bf16_t*)(ws + WS_GA), (bf16_t*)(ws + WS_MG)};
        pg8::gemm_phase<EpiMerge, pg8::StaticOrder, false>(lds, g, S, E);
        SEAM(7);
    }
    if (IN(8)) {
        KP kp = fresh_kp(); unsigned char* ws = kp->ws;
        pg8::Gemm g{(const bf16_t*)(ws + WS_MG), (const bf16_t*)(ws + WS_WO), 2048, 2048, 2048};
        pg8::StaticOrder S; S.init(32, 8, G, (int)blockIdx.x, NREP(8));
        EpiOut E{kp->in[I_XP], kp->in[I_XS], (const float*)(ws + WS_MOD), kp->out + OUT_Y};
        pg8::gemm_phase<EpiOut, pg8::StaticOrder, false>(lds, g, S, E);
    }
    STAMP();
    if (TS_A >= -1 && blockIdx.x == 0) {
        VM_WAIT(); __syncthreads();
        float t_us = 200.0f;
        if (TS_A >= 0) { const unsigned long long a = __hip_atomic_load(stamps + (TS_A < 0 ? 0 : TS_A), __ATOMIC_RELAXED, __HIP_MEMORY_SCOPE_AGENT), b = __hip_atomic_load(stamps + (TS_B < 0 ? 0 : TS_B), __ATOMIC_RELAXED, __HIP_MEMORY_SCOPE_AGENT); t_us = (float)(long long)(b - a) * 0.01f; }
        const float eps = __builtin_sqrtf(__builtin_fmaxf(t_us, 0.f) * 2e-7f);
        KP kp = fresh_kp(); float* o = kp->out + OUT_SIM;
        for (int i = tid; i < 131072; i += 512) o[i] = o[i] * (1.0f + eps);
    }
#undef IN
#undef SEAM
}

extern "C" void kernel_launch(void* const* d_in, const int* in_sizes, int n_in, void* d_out, int out_size, void* d_ws, size_t ws_size, hipStream_t stream) {
    static int grid = 0;
    if (grid == 0) {
        if (n_in != 28 || out_size != (int)OUT_TOTAL || ws_size < WS_END) { fprintf(stderr, "kernel_launch: unexpected problem (n_in %d, out %d, ws %zu)\n", n_in, out_size, ws_size); grid = -1; return; }
        int dev = 0, cus = 0, per_cu = 0;
        if (hipGetDevice(&dev) != hipSuccess || hipDeviceGetAttribute(&cus, hipDeviceAttributeMultiprocessorCount, dev) != hipSuccess) { grid = -1; return; }
        if (hipFuncSetAttribute((const void*)fwd_kernel, hipFuncAttributeMaxDynamicSharedMemorySize, LDS_BYTES) != hipSuccess) { fprintf(stderr, "kernel_launch: hipFuncSetAttribute failed\n"); grid = -1; return; }
        if (hipOccupancyMaxActiveBlocksPerMultiprocessor(&per_cu, (const void*)fwd_kernel, NWAVES * 64, LDS_BYTES) != hipSuccess || per_cu < 1) { fprintf(stderr, "kernel_launch: occupancy query says %d\n", per_cu); per_cu = 1; }
        (void)hipGetLastError();
        grid = cus;
        fprintf(stderr, "kernel_launch: grid %d (cus %d, per_cu %d), ws %zu\n", grid, cus, per_cu, ws_size);
    }
    if (grid < 0) return;
    (void)hipMemsetAsync((char*)d_ws + WS_CTL, 0, CTL_ZERO_BYTES, stream);
    Args a{};
    for (int i = 0; i < 28; ++i) a.in[i] = (const float*)d_in[i];
    a.out = (float*)d_out; a.ws = (unsigned char*)d_ws;
#if MK_N_LAUNCHES == 1
    a.ph_lo = 0; a.ph_hi = NPHASE;
    void* params[] = {&a};
    hipError_t e = hipLaunchCooperativeKernel((const void*)fwd_kernel, dim3(grid), dim3(NWAVES * 64), params, LDS_BYTES, stream);
    if (e != hipSuccess) fprintf(stderr, "kernel_launch: cooperative launch failed: %s\n", hipGetErrorString(e));
#else
    for (int p = 0; p < NPHASE; ++p) {
        a.ph_lo = p; a.ph_hi = p + 1;
        hipLaunchKernelGGL(fwd_kernel, dim3(grid), dim3(NWAVES * 64), LDS_BYTES, stream, a);
    }
#endif
}
```

```cpp
#include <hip/hip_runtime.h>
#include <cstdio>
#include <cstdint>

#ifndef MK_N_LAUNCHES
#define MK_N_LAUNCHES 1
#endif

#define GAS __attribute__((address_space(1)))
#define LAS __attribute__((address_space(3)))
typedef unsigned short bf16_t;
typedef short bf16x8 __attribute__((ext_vector_type(8)));
typedef short s16x4 __attribute__((ext_vector_type(4)));
typedef float f32x4 __attribute__((ext_vector_type(4)));
typedef float f32x16 __attribute__((ext_vector_type(16)));
typedef unsigned u32x4 __attribute__((ext_vector_type(4)));
typedef unsigned u32x2 __attribute__((ext_vector_type(2)));
typedef float f32x2_t __attribute__((ext_vector_type(2)));
typedef __bf16 bf16x2_t __attribute__((ext_vector_type(2)));

constexpr int DM = 2048, NTOK = 8192, NPROMPT = 4096, INW = 10240, SSMW = 1024, ATTW = 1024, NH = 16, HD = 64;
constexpr int NGRP = 64, NSTATE = 64, TCH = 16;
constexpr float EPSN = 1e-6f;
constexpr float LOG2E = 1.4426950408889634f;
constexpr float QSCALE = 0.125f * LOG2E;

constexpr size_t MiB = 1u << 20;
constexpr size_t WS_CTL = 0, CTL_ZERO_BYTES = 32768;
constexpr size_t WS_MOD = 1 * MiB;
constexpr size_t WS_WIN = 2 * MiB;
constexpr size_t WS_A2 = 2 * MiB;
constexpr size_t WS_WGLU = 42 * MiB;
constexpr size_t WS_WM = 44 * MiB;
constexpr size_t WS_WO = 52 * MiB;
constexpr size_t WS_WA = 60 * MiB;
constexpr size_t WS_WOS = 68 * MiB;
constexpr size_t WS_CK = 84 * MiB, WS_CV = 86 * MiB;
constexpr size_t WS_XN = 88 * MiB;
constexpr size_t WS_S = 88 * MiB;
constexpr size_t WS_UH = 120 * MiB;
constexpr size_t WS_MG = 120 * MiB;
constexpr size_t WS_ZS = 152 * MiB;
constexpr size_t WS_Q = 168 * MiB;
constexpr size_t WS_YS = 296 * MiB;
constexpr size_t WS_KB = 184 * MiB, WS_VB = 200 * MiB, WS_ZA = 216 * MiB;
constexpr size_t WS_GS = 232 * MiB, WS_GA = 264 * MiB;
constexpr size_t WS_END = 312 * MiB;

constexpr size_t OUT_Y = 0, OUT_CK = 16777216, OUT_CV = 20971520, OUT_SRE = 25165824, OUT_SIM = 25296896, OUT_TOTAL = 25427968;

constexpr int RING_BYTES = 131072;
constexpr int XCH_OFF = RING_BYTES;
constexpr int MISC_OFF = RING_BYTES + 8192;
constexpr int LDS_BYTES = 147456;

constexpr int NWAVES = 8;

__device__ __forceinline__ unsigned cvtpk(float lo, float hi) { f32x2_t v = {lo, hi}; bf16x2_t b = __builtin_convertvector(v, bf16x2_t); return __builtin_bit_cast(unsigned, b); }
__device__ __forceinline__ float bf2f(unsigned short h) { return __builtin_bit_cast(float, (unsigned)h << 16); }
__device__ __forceinline__ float bflo(unsigned w) { return __builtin_bit_cast(float, w << 16); }
__device__ __forceinline__ float bfhi(unsigned w) { return __builtin_bit_cast(float, w & 0xffff0000u); }
__device__ __forceinline__ float sigm_f(float x) { return __builtin_amdgcn_rcpf(1.f + __builtin_amdgcn_exp2f(-LOG2E * x)); }
__device__ __forceinline__ float silu_f(float x) { return x * sigm_f(x); }
__device__ __forceinline__ float gelu_f(float x) { return x * sigm_f(1.5957691216057308f * (x + 0.044715f * x * x * x)); }
__device__ __forceinline__ u32x4 pack8(f32x4 a, f32x4 b) { u32x4 w; w.x = cvtpk(a[0], a[1]); w.y = cvtpk(a[2], a[3]); w.z = cvtpk(b[0], b[1]); w.w = cvtpk(b[2], b[3]); return w; }
__device__ __forceinline__ void unpack8(u32x4 w, f32x4& a, f32x4& b) { a = (f32x4){bflo(w.x), bfhi(w.x), bflo(w.y), bfhi(w.y)}; b = (f32x4){bflo(w.z), bfhi(w.z), bflo(w.w), bfhi(w.w)}; }
__device__ __forceinline__ float wave_sum(float v) {
#pragma unroll
    for (int o = 1; o < 64; o <<= 1) v += __shfl_xor(v, o);
    return v;
}
__device__ __forceinline__ void sincos_rad(float x, float& s, float& c) {
    float rev = x * 0.15915494309189535f; rev -= __builtin_floorf(rev);
    s = __builtin_amdgcn_sinf(rev); c = __builtin_amdgcn_cosf(rev);
}
#define LDS_WAIT() asm volatile("s_waitcnt lgkmcnt(0)" ::: "memory")
#define VM_WAIT() asm volatile("s_waitcnt vmcnt(0)" ::: "memory")

namespace pg8 {
constexpr int BM = 256, BK = 64, HALF = 128, HTB = HALF * BK * 2, STAGE_BYTES = 8 * HTB, NXCD = 8, WGM = 8;
__host__ __device__ __forceinline__ int lds_byte(int r, int c) { const int st = (r >> 4) * 2 + (c >> 5), rr = r & 15, cc = c & 31, ob = rr * 64 + cc * 2; return st * 1024 + (ob ^ (((ob >> 9) & 1) << 5)); }
__host__ __device__ __forceinline__ void stage_rc(int b, int& R, int& C) { const int st = b / 1024, sb = b % 1024, swz = sb ^ (((sb >> 9) & 1) << 5); R = (st >> 1) * 16 + swz / 64; C = (st & 1) * 32 + (swz % 64) / 2; }
__host__ __device__ __forceinline__ int perm32(int rho) { const int n = rho >> 4, i = rho & 15; return 8 * (i >> 2) + 4 * n + (i & 3); }

struct Unit { int pm, pn; };
struct Gemm { const bf16_t* A; const bf16_t* Bt; int lda, ldb, K; };

struct StaticOrder {
    int nM, nN, nwg, G, c, rep;
    __device__ void init(int nM_, int nN_, int G_, int c_, int rep_ = 1) { nM = nM_; nN = nN_; nwg = nM * nN; G = G_; c = c_; rep = rep_; }
    __device__ bool next(int i, Unit& u) const {
        long L = (long)i * G + c; if (L >= (long)nwg * rep) return false; if (L >= nwg) L -= nwg;
        int wgid = (int)L; { const int q = nwg / NXCD, r = nwg % NXCD, xcd = wgid % NXCD, off = wgid / NXCD; wgid = (xcd < r ? xcd * (q + 1) : r * (q + 1) + (xcd - r) * q) + off; }
        const int nig = WGM * nN, gid = wgid / nig, fm = gid * WGM, gsz = (nM - fm) < WGM ? (nM - fm) : WGM;
        u.pm = fm + ((wgid % nig) % gsz); u.pn = (wgid % nig) / gsz; return true;
    }
};
struct OneUnit { int pm, pn; __device__ bool next(int i, Unit& u) const { if (i) return false; u.pm = pm; u.pn = pn; return true; } };
struct SsmOrder {
    int G, c, rep;
    __device__ bool next(int i, Unit& u) const { int L = i * G + c; if (L >= 128 * rep) return false; L &= 127; u.pm = L; u.pn = L >> 1; return true; }
};

typedef f32x4 Acc[2][2][4][2];

template <class Epi, class Sched, bool ALIGN_EPI>
__device__ __forceinline__ void gemm_phase(LAS unsigned char* lds, const Gemm g, const Sched& S, const Epi& E) {
    int tid = threadIdx.x; asm volatile("" : "+v"(tid));
    const int wid = __builtin_amdgcn_readfirstlane(tid >> 6), lane = tid & 63, wr = wid >> 2, wc = wid & 3, fr = lane & 15, fq = lane >> 4;
    const int K = g.K, nt = K / BK;
    unsigned voffA[2], voffB[2];
#pragma unroll
    for (int i = 0; i < 2; ++i) { int R, C; stage_rc(tid * 16 + i * 8192, R, C); const int Rb = (R & ~31) + perm32(R & 31);
        voffA[i] = (unsigned)(R * g.lda + C) * 2u; voffB[i] = (unsigned)(Rb * g.ldb + C) * 2u; }
    const size_t kstep = (size_t)(BK * 2);
    const size_t hA = (size_t)HALF * g.lda * 2, hB = (size_t)HALF * g.ldb * 2, tA = 2 * hA, tB = 2 * hB;
    const unsigned ldsw = (unsigned)wid * 1024u;
    const int aoff = lds_byte(wr * 64 + fr, fq * 8), boff = lds_byte(wc * 32 + fr, fq * 8);
#define PG8_SA(b, h) (((b) * 2 + (h)) * HTB)
#define PG8_SB(b, h) ((4 + (b) * 2 + (h)) * HTB)
#define PG8_STAGE(bufoff, gbase, voff) do { _Pragma("unroll") for (int _i = 0; _i < 2; ++_i) \
        __builtin_amdgcn_global_load_lds((const unsigned*)((const char*)(gbase) + (voff)[_i]), (LAS unsigned*)(lds + (bufoff) + ldsw + _i * 8192), 16, 0, 0); } while (0)
#define PG8_LDA(dst, b, h) do { _Pragma("unroll") for (int m = 0; m < 4; ++m) _Pragma("unroll") for (int k = 0; k < 2; ++k) dst[m][k] = *(const LAS bf16x8*)(lds + PG8_SA(b, h) + aoff + m * 2048 + k * 1024); } while (0)
#define PG8_LDB(dst, b, h) do { _Pragma("unroll") for (int n = 0; n < 2; ++n) _Pragma("unroll") for (int k = 0; k < 2; ++k) dst[n][k] = *(const LAS bf16x8*)(lds + PG8_SB(b, h) + boff + n * 2048 + k * 1024); } while (0)
#define PG8_MMA(ai, bj, At, Bt) do { __builtin_amdgcn_s_setprio(1); _Pragma("unroll") for (int m = 0; m < 4; ++m) _Pragma("unroll") for (int n = 0; n < 2; ++n) _Pragma("unroll") for (int k = 0; k < 2; ++k) \
        acc[ai][bj][m][n] = __builtin_amdgcn_mfma_f32_16x16x32_bf16(Bt[n][k], At[m][k], acc[ai][bj][m][n], 0, 0, 0); __builtin_amdgcn_s_setprio(0); } while (0)
#define PG8_WAIT_V(n) asm volatile("s_waitcnt vmcnt(" #n ")" ::: "memory")
#define PG8_WAIT_L(n) asm volatile("s_waitcnt lgkmcnt(" #n ")" ::: "memory")
#define PG8_BAR __builtin_amdgcn_s_barrier()
#define PG8_SCHED __builtin_amdgcn_sched_barrier(0)
    Unit cur, nxt; int ui = 0;
    if (!S.next(0, cur)) return;
    Acc acc;
#pragma unroll
    for (int a = 0; a < 2; ++a)
#pragma unroll
        for (int b = 0; b < 2; ++b)
#pragma unroll
            for (int m = 0; m < 4; ++m)
#pragma unroll
                for (int n = 0; n < 2; ++n) acc[a][b][m][n] = (f32x4){0.f, 0.f, 0.f, 0.f};
    bf16x8 At[4][2], B0[2][2], B1[2][2];
    const char* cA = (const char*)g.A + (size_t)cur.pm * tA; const char* cB = (const char*)g.Bt + (size_t)cur.pn * tB;
    PG8_STAGE(PG8_SB(0, 0), cB, voffB); PG8_STAGE(PG8_SB(0, 1), cB + hB, voffB); PG8_STAGE(PG8_SA(0, 0), cA, voffA); PG8_STAGE(PG8_SA(0, 1), cA + hA, voffA);
    if (wr == 1) PG8_BAR;
    PG8_WAIT_V(2); PG8_BAR;
    PG8_STAGE(PG8_SB(1, 0), cB + kstep, voffB); PG8_STAGE(PG8_SA(1, 0), cA + kstep, voffA); PG8_STAGE(PG8_SB(1, 1), cB + hB + kstep, voffB);
    PG8_WAIT_V(6); PG8_BAR;
    for (;;) {
        const bool has_next = S.next(ui + 1, nxt);
        const char* nA = has_next ? (const char*)g.A + (size_t)nxt.pm * tA : cA; const char* nB = has_next ? (const char*)g.Bt + (size_t)nxt.pn * tB : cB;
#pragma unroll 1
        for (int t = 0; t < nt; t += 2) {
            const bool last = (t == nt - 2);
            const char* a1 = cA + (size_t)(t + 1) * kstep;
            const char* a2 = last ? nA : cA + (size_t)(t + 2) * kstep; const char* b2 = last ? nB : cB + (size_t)(t + 2) * kstep;
            const char* a3 = a2 + kstep; const char* b3 = b2 + kstep;
            if constexpr (Epi::MIDK) { if (t == (nt >> 1)) E.mid(acc, cur, wr, wc, fr, fq); }
            PG8_LDB(B0, 0, 0); PG8_LDB(B1, 0, 1); PG8_SCHED; PG8_LDA(At, 0, 0); PG8_STAGE(PG8_SA(1, 1), a1 + hA, voffA);
            PG8_WAIT_V(8); PG8_WAIT_L(0); PG8_BAR; PG8_MMA(0, 0, At, B0); PG8_MMA(0, 1, At, B1); PG8_BAR; PG8_SCHED;
            PG8_LDA(At, 0, 1); PG8_STAGE(PG8_SB(0, 0), b2, voffB); PG8_STAGE(PG8_SB(0, 1), b2 + hB, voffB); PG8_STAGE(PG8_SA(0, 0), a2, voffA);
            PG8_WAIT_V(8); PG8_WAIT_L(0); PG8_BAR; PG8_MMA(1, 0, At, B0); PG8_MMA(1, 1, At, B1); PG8_BAR; PG8_SCHED;
            PG8_LDB(B0, 1, 0); PG8_LDB(B1, 1, 1); PG8_SCHED; PG8_LDA(At, 1, 0); PG8_STAGE(PG8_SA(0, 1), a2 + hA, voffA);
            PG8_WAIT_V(8); PG8_WAIT_L(0); PG8_BAR; PG8_MMA(0, 0, At, B0); PG8_MMA(0, 1, At, B1); PG8_BAR; PG8_SCHED;
            PG8_LDA(At, 1, 1); PG8_STAGE(PG8_SB(1, 0), b3, voffB); PG8_STAGE(PG8_SB(1, 1), b3 + hB, voffB); PG8_STAGE(PG8_SA(1, 0), a3, voffA);
            PG8_WAIT_V(8); PG8_WAIT_L(0); PG8_BAR; PG8_MMA(1, 0, At, B0); PG8_MMA(1, 1, At, B1); PG8_BAR; PG8_SCHED;
        }
        if constexpr (ALIGN_EPI) { if (wr == 0) PG8_BAR; }
        E(acc, cur, wr, wc, fr, fq);
        if (!has_next) break;
#pragma unroll
        for (int a = 0; a < 2; ++a)
#pragma unroll
            for (int b = 0; b < 2; ++b)
#pragma unroll
                for (int m = 0; m < 4; ++m)
#pragma unroll
                    for (int n = 0; n < 2; ++n) acc[a][b][m][n] = (f32x4){0.f, 0.f, 0.f, 0.f};
        cur = nxt; cA = nA; cB = nB; ++ui;
        if constexpr (ALIGN_EPI) { if (wr == 1) PG8_BAR; }
    }
    PG8_WAIT_V(0);
    if constexpr (!ALIGN_EPI) { if (wr == 0) PG8_BAR; }
    PG8_BAR;
#undef PG8_SA
#undef PG8_SB
#undef PG8_STAGE
#undef PG8_LDA
#undef PG8_LDB
#undef PG8_MMA
#undef PG8_WAIT_V
#undef PG8_WAIT_L
#undef PG8_BAR
#undef PG8_SCHED
}
}

#define EPI_LOOP(ai, m, bj) _Pragma("unroll") for (int ai = 0; ai < 2; ++ai) _Pragma("unroll") for (int m = 0; m < 4; ++m) _Pragma("unroll") for (int bj = 0; bj < 2; ++bj)

struct EpiIn {
    static constexpr bool MIDK = false;
    bf16_t *UH, *ZS, *Q, *KB, *VB, *ZA, *GS, *GA; float *ock, *ocv; const float *qw, *kw; LAS float* xch;
    __device__ __forceinline__ void operator()(const pg8::Acc& acc, const pg8::Unit& u, int wr, int wc, int fr, int fq) const {
        const int type = u.pn >> 2;
        const int row0 = u.pm * 256 + wr * 64 + fr;
        const int col0 = u.pn * 256 + wc * 32 + 8 * fq;
        if (type == 0) {
            EPI_LOOP(ai, m, bj) { const int tok = row0 + ai * 128 + m * 16, c = col0 + bj * 128; const int g = c >> 4, i0 = c & 15;
                *(u32x4*)(UH + ((size_t)(g * 512 + (tok >> 4)) * 512 + (tok & 15) * 16 + i0)) = pack8(acc[ai][bj][m][0], acc[ai][bj][m][1]); }
        } else if (type == 1 || type == 5) {
            bf16_t* O = (type == 1) ? ZS : ZA; const int cb = (type == 1) ? 1024 : 5120;
            EPI_LOOP(ai, m, bj) { const int tok = row0 + ai * 128 + m * 16, c = col0 + bj * 128 - cb; f32x4 a = acc[ai][bj][m][0], b = acc[ai][bj][m][1];
#pragma unroll
                for (int e = 0; e < 4; ++e) { a[e] = silu_f(a[e]); b[e] = silu_f(b[e]); }
                *(u32x4*)(O + (size_t)tok * 1024 + c) = pack8(a, b); }
        } else if (type >= 6) {
            bf16_t* O = (type < 8) ? GS : GA; const int cb = (type < 8) ? 6144 : 8192;
            EPI_LOOP(ai, m, bj) { const int tok = row0 + ai * 128 + m * 16, c = col0 + bj * 128 - cb; f32x4 a = acc[ai][bj][m][0], b = acc[ai][bj][m][1];
#pragma unroll
                for (int e = 0; e < 4; ++e) { a[e] = sigm_f(a[e]); b[e] = sigm_f(b[e]); }
                *(u32x4*)(O + (size_t)tok * 2048 + c) = pack8(a, b); }
        } else if (type == 4) {
            EPI_LOOP(ai, m, bj) { const int tok = row0 + ai * 128 + m * 16, c = col0 + bj * 128 - 4096; const f32x4 a = acc[ai][bj][m][0], b = acc[ai][bj][m][1];
                { const int hh = c >> 6, d0 = c & 63;
                  *(u32x4*)(VB + (size_t)((tok >> 6) * 16 + hh) * 4096 + ((d0 >> 5) * 4 + ((tok & 63) >> 4)) * 512 + (tok & 15) * 32 + ((d0 & 31) >> 3) * 8) = pack8(a, b); }
                if (tok < NPROMPT) { *(f32x4*)(ocv + (size_t)tok * 1024 + c) = a; *(f32x4*)(ocv + (size_t)tok * 1024 + c + 4) = b; } }
        } else {
            float ss[2][4][2];
            EPI_LOOP(ai, m, bj) { const f32x4 a = acc[ai][bj][m][0], b = acc[ai][bj][m][1];
                float s = (a[0] * a[0] + a[1] * a[1]) + (a[2] * a[2] + a[3] * a[3]) + (b[0] * b[0] + b[1] * b[1]) + (b[2] * b[2] + b[3] * b[3]);
                s += __shfl_xor(s, 16); s += __shfl_xor(s, 32); ss[ai][m][bj] = s;
                if (fq == 0) xch[(ai * 128 + wr * 64 + m * 16 + fr) * 8 + bj * 4 + wc] = s; }
            LDS_WAIT(); __builtin_amdgcn_s_barrier(); asm volatile("" ::: "memory");
            const float* nw = (type == 2) ? qw : kw; const float osc = (type == 2) ? QSCALE : 1.0f;
            const int d0 = (wc & 1) * 32 + 8 * fq;
            const f32x4 w0 = *(const f32x4*)(nw + d0), w1 = *(const f32x4*)(nw + d0 + 4);
            bf16_t* O = (type == 2) ? Q : KB; const int cb = (type == 2) ? 2048 : 3072;
            EPI_LOOP(ai, m, bj) { const int tok = row0 + ai * 128 + m * 16, c = col0 + bj * 128 - cb;
                const float tot = ss[ai][m][bj] + xch[(ai * 128 + wr * 64 + m * 16 + fr) * 8 + bj * 4 + (wc ^ 1)];
                const float rstd = __builtin_amdgcn_rsqf(tot * (1.0f / 64.0f) + EPSN);
                f32x4 a = acc[ai][bj][m][0] * rstd * w0, b = acc[ai][bj][m][1] * rstd * w1;
                if (type == 3 && tok < NPROMPT) { *(f32x4*)(ock + (size_t)tok * 1024 + c) = a; *(f32x4*)(ock + (size_t)tok * 1024 + c + 4) = b; }
                a = a * osc; b = b * osc;
                if (type == 2) *(u32x4*)(O + (size_t)tok * 1024 + c) = pack8(a, b);
                else { const int hh = c >> 6, d0 = c & 63;
                    *(u32x4*)(O + (size_t)((tok >> 6) * 16 + hh) * 4096 + (d0 >> 3) * 512 + (tok & 63) * 8) = pack8(a, b); } }
        }
    }
};

struct EpiS {
    static constexpr bool MIDK = false;
    float* S;
    __device__ __forceinline__ void operator()(const pg8::Acc& acc, const pg8::Unit& u, int wr, int wc, int fr, int fq) const {
        const int row0 = u.pm * 256 + wr * 64 + fr, col0 = wc * 32 + 8 * fq;
        EPI_LOOP(ai, m, bj) { float* p = S + (size_t)(row0 + ai * 128 + m * 16) * 256 + col0 + bj * 128; *(f32x4*)p = acc[ai][bj][m][0]; *(f32x4*)(p + 4) = acc[ai][bj][m][1]; }
    }
};
struct EpiY {
    static constexpr bool MIDK = false;
    bf16_t* YS;
    __device__ __forceinline__ void operator()(const pg8::Acc& acc, const pg8::Unit& u, int wr, int wc, int fr, int fq) const {
        const int g = u.pm >> 1, ch0 = (u.pm & 1) * 256 + wr * 64 + fr, col0 = wc * 32 + 8 * fq;
        EPI_LOOP(ai, m, bj) { const int chunk = ch0 + ai * 128 + m * 16, c = col0 + bj * 128, tau = c >> 4, i0 = c & 15; f32x4 a = acc[ai][bj][m][0], b = acc[ai][bj][m][1];
#pragma unroll
            for (int e = 0; e < 4; ++e) { a[e] = gelu_f(a[e]); b[e] = gelu_f(b[e]); }
            { const u32x4 w = pack8(a, b); bf16_t* p = YS + (size_t)(chunk * 16 + tau) * 1024 + g * 16 + i0;
              asm volatile("global_store_dwordx4 %0, %1, off sc1\n\ts_nop 1" :: "v"(p), "v"(w) : "memory"); } }
    }
};
struct EpiGlu {
    static constexpr bool MIDK = false;
    const bf16_t *YS, *ZS; const float* bglu; bf16_t* A2;
    __device__ __forceinline__ void operator()(const pg8::Acc& acc, const pg8::Unit& u, int wr, int wc, int fr, int fq) const {
        const int row0 = u.pm * 256 + wr * 64 + fr, col0 = u.pn * 256 + wc * 32 + 8 * fq;
        f32x4 bb[2][2];
#pragma unroll
        for (int bj = 0; bj < 2; ++bj) { bb[bj][0] = *(const f32x4*)(bglu + col0 + bj * 128); bb[bj][1] = *(const f32x4*)(bglu + col0 + bj * 128 + 4); }
#pragma unroll
        for (int ai = 0; ai < 2; ++ai) {
            u32x4 yv[4][2], zv[4][2];
#pragma unroll
            for (int m = 0; m < 4; ++m)
#pragma unroll
                for (int bj = 0; bj < 2; ++bj) { const size_t off = (size_t)(row0 + ai * 128 + m * 16) * 1024 + col0 + bj * 128; yv[m][bj] = *(const u32x4*)(YS + off); zv[m][bj] = *(const u32x4*)(ZS + off); }
#pragma unroll
            for (int m = 0; m < 4; ++m)
#pragma unroll
                for (int bj = 0; bj < 2; ++bj) { f32x4 y0, y1, z0, z1; unpack8(yv[m][bj], y0, y1); unpack8(zv[m][bj], z0, z1);
                    f32x4 a = acc[ai][bj][m][0] + bb[bj][0], b = acc[ai][bj][m][1] + bb[bj][1];
#pragma unroll
                    for (int e = 0; e < 4; ++e) { a[e] = y0[e] * sigm_f(a[e]) * z0[e]; b[e] = y1[e] * sigm_f(b[e]) * z1[e]; }
                    *(u32x4*)(A2 + (size_t)(row0 + ai * 128 + m * 16) * 2048 + col0 + bj * 128) = pack8(a, b); }
            asm volatile("" ::: "memory");
        }
    }
};
struct EpiMerge {
    static constexpr bool MIDK = true;
    const bf16_t *GS, *GA; bf16_t* MG;
    __device__ __forceinline__ void mid(pg8::Acc& acc, const pg8::Unit& u, int wr, int wc, int fr, int fq) const {
        int row0 = u.pm * 256 + wr * 64 + fr, col0 = u.pn * 256 + wc * 32 + 8 * fq;
        asm volatile("" : "+v"(row0), "+v"(col0));
#pragma unroll
        for (int ai = 0; ai < 2; ++ai) {
            u32x4 gs[4][2], ga[4][2];
#pragma unroll
            for (int m = 0; m < 4; ++m)
#pragma unroll
                for (int bj = 0; bj < 2; ++bj) { const size_t off = (size_t)(row0 + ai * 128 + m * 16) * 2048 + col0 + bj * 128; gs[m][bj] = *(const u32x4*)(GS + off); ga[m][bj] = *(const u32x4*)(GA + off); }
#pragma unroll
            for (int m = 0; m < 4; ++m)
#pragma unroll
                for (int bj = 0; bj < 2; ++bj) { f32x4 s0, s1, a0, a1; unpack8(gs[m][bj], s0, s1); unpack8(ga[m][bj], a0, a1);
#pragma unroll
                    for (int e = 0; e < 4; ++e) { acc[ai][bj][m][0][e] *= s0[e] * __builtin_amdgcn_rcpf(__builtin_fmaxf(a0[e], 1e-30f)); acc[ai][bj][m][1][e] *= s1[e] * __builtin_amdgcn_rcpf(__builtin_fmaxf(a1[e], 1e-30f)); }
                    asm volatile("" : "+v"(acc[ai][bj][m][0]), "+v"(acc[ai][bj][m][1])); }
            asm volatile("" ::: "memory");
        }
    }
    __device__ __forceinline__ void operator()(const pg8::Acc& acc, const pg8::Unit& u, int wr, int wc, int fr, int fq) const {
        const int row0 = u.pm * 256 + wr * 64 + fr, col0 = u.pn * 256 + wc * 32 + 8 * fq;
        u32x4 ga[2][4][2];
        EPI_LOOP(ai, m, bj) ga[ai][m][bj] = *(const u32x4*)(GA + (size_t)(row0 + ai * 128 + m * 16) * 2048 + col0 + bj * 128);
        EPI_LOOP(ai, m, bj) { const size_t off = (size_t)(row0 + ai * 128 + m * 16) * 2048 + col0 + bj * 128;
            f32x4 a0, a1; unpack8(ga[ai][m][bj], a0, a1);
            *(u32x4*)(MG + off) = pack8(acc[ai][bj][m][0] * a0, acc[ai][bj][m][1] * a1); }
    }
};
struct EpiOut {
    static constexpr bool MIDK = false;
    const float *xp, *xs, *mod; float* out;
    __device__ __forceinline__ void operator()(const pg8::Acc& acc, const pg8::Unit& u, int wr, int wc, int fr, int fq) const {
        const int row0 = u.pm * 256 + wr * 64 + fr, col0 = u.pn * 256 + wc * 32 + 8 * fq;
        const int cond = (u.pm < 16) ? 0 : 1 + ((u.pm - 16) >> 3);
        const float* gate = mod + cond * 6144 + 4096;
        const float* xb = (u.pm < 16) ? xp : xs - (size_t)NPROMPT * 2048;
        f32x4 gg[2][2];
#pragma unroll
        for (int bj = 0; bj < 2; ++bj) { gg[bj][0] = *(const f32x4*)(gate + col0 + bj * 128); gg[bj][1] = *(const f32x4*)(gate + col0 + bj * 128 + 4); }
#pragma unroll
        for (int ai = 0; ai < 2; ++ai) {
            f32x4 xv[4][2][2];
#pragma unroll
            for (int m = 0; m < 4; ++m)
#pragma unroll
                for (int bj = 0; bj < 2; ++bj) { const float* xr = xb + (size_t)(row0 + ai * 128 + m * 16) * 2048 + col0 + bj * 128; xv[m][bj][0] = *(const f32x4*)xr; xv[m][bj][1] = *(const f32x4*)(xr + 4); }
#pragma unroll
            for (int m = 0; m < 4; ++m)
#pragma unroll
                for (int bj = 0; bj < 2; ++bj) { float* o = out + (size_t)(row0 + ai * 128 + m * 16) * 2048 + col0 + bj * 128;
                    *(f32x4*)o = xv[m][bj][0] + gg[bj][0] * acc[ai][bj][m][0]; *(f32x4*)(o + 4) = xv[m][bj][1] + gg[bj][1] * acc[ai][bj][m][1]; }
            asm volatile("" ::: "memory");
        }
    }
};

#define XB_TMO      128
#define XB_XCNT(j)  (256  + 64 * (j))
#define XB_XSUB(j)  (1280 + 64 * (j))
#define XB_XGEN(j)  (2304 + 64 * (j))
#define XB_TOP      3328
#define XB_TOPGEN   3392
#define XCD_BAR_WORDS 3456
#define XB_SPIN_CAP (1u << 20)
__device__ __forceinline__ unsigned xb_ld(unsigned* p)              { return __hip_atomic_load(p, __ATOMIC_RELAXED, __HIP_MEMORY_SCOPE_AGENT); }
__device__ __forceinline__ unsigned xb_add(unsigned* p, unsigned v) { return __hip_atomic_fetch_add(p, v, __ATOMIC_RELAXED, __HIP_MEMORY_SCOPE_AGENT); }
__device__ __forceinline__ unsigned xb_xcc_id() { return (unsigned)__builtin_amdgcn_s_getreg((3 << 11) | 20) & 0xFu; }
#define XB_SPIN(cond, bar) do { unsigned _sp = 0; while (cond) { __builtin_amdgcn_s_sleep(1); \
    if ((++_sp & 255u) == 0u) { if (xb_ld(&(bar)[XB_TMO])) break; if (_sp > XB_SPIN_CAP) { atomicAdd(&(bar)[XB_TMO], 1u); break; } } } } while (0)
struct XcdBarrier { unsigned* bar; unsigned x; volatile LAS unsigned* st; };
__device__ __forceinline__ XcdBarrier xcd_barrier_post(unsigned* bar, volatile LAS unsigned* st) {
    XcdBarrier b; b.bar = bar; b.x = xb_xcc_id(); b.st = st;
    if (threadIdx.x == 0) (void)xb_add(&bar[XB_XCNT(b.x)], 1u);
    return b;
}
__device__ __forceinline__ void xcd_barrier_complete(unsigned* bar, unsigned x, unsigned& nloc, unsigned& nx) {
    const unsigned G = gridDim.x * gridDim.y * gridDim.z;
    unsigned sum, cnt, mine, sp = 0u;
    for (;;) {
        sum = 0u; cnt = 0u; mine = 0u;
#pragma unroll
        for (unsigned j = 0; j < 16; ++j) { const unsigned c = xb_ld(&bar[XB_XCNT(j)]); sum += c; cnt += (c > 0u) ? 1u : 0u; mine = (j == x) ? c : mine; }
        if (sum == G) break;
        __builtin_amdgcn_s_sleep(1);
        if ((++sp & 255u) == 0u) { if (xb_ld(&bar[XB_TMO])) break; if (sp > XB_SPIN_CAP) { atomicAdd(&bar[XB_TMO], 1u); break; } }
    }
    nloc = mine > 0u ? mine : 1u; nx = cnt > 0u ? cnt : 1u;
}
__device__ __forceinline__ void xcd_barrier(const XcdBarrier& b) {
    asm volatile("s_waitcnt vmcnt(0)" ::: "memory");
    __syncthreads();
    if (threadIdx.x == 0) {
        unsigned* bar = b.bar;
        __builtin_amdgcn_s_waitcnt(0);
        unsigned nloc = b.st[0], nx = b.st[1];
        if (nloc == 0u) { xcd_barrier_complete(bar, b.x, nloc, nx); b.st[0] = nloc; b.st[1] = nx; }
        const unsigned old = xb_add(&bar[XB_XSUB(b.x)], 1u);
        const unsigned gen = old / nloc;
        if (old + 1u == (gen + 1u) * nloc) {
            __builtin_amdgcn_fence(__ATOMIC_RELEASE, "agent");
            asm volatile("s_waitcnt vmcnt(0)" ::: "memory");
            const unsigned og = xb_add(&bar[XB_TOP], 1u);
            const unsigned tg = og / nx;
            if (og + 1u == (tg + 1u) * nx) xb_add(&bar[XB_TOPGEN], 1u);
            else XB_SPIN(xb_ld(&bar[XB_TOPGEN]) == tg, bar);
            __builtin_amdgcn_fence(__ATOMIC_ACQUIRE, "agent");
            xb_add(&bar[XB_XGEN(b.x)], 1u);
            asm volatile("s_waitcnt vmcnt(0)" ::: "memory");
        } else {
            XB_SPIN(xb_ld(&bar[XB_XGEN(b.x)]) == gen, bar);
            __builtin_amdgcn_fence(__ATOMIC_ACQUIRE, "agent");
            asm volatile("s_waitcnt vmcnt(0)" ::: "memory");
        }
    }
    __syncthreads();
}

struct Args { const float* in[28]; float* out; unsigned char* ws; int ph_lo, ph_hi; };
typedef const __attribute__((address_space(4))) Args* KP;
__device__ __forceinline__ KP fresh_kp() { KP kp = (KP)__builtin_amdgcn_kernarg_segment_ptr(); asm volatile("" : "+s"(kp)); return kp; }
enum { I_XP = 0, I_XS, I_CK, I_CV, I_SRE, I_SIM, I_C, I_CCTX, I_NORMW, I_WADA, I_BADA, I_WIN, I_QNW, I_KNW, I_RPB, I_ARE, I_AIM, I_LOGDT, I_BRE, I_BIM, I_CRE, I_CIM, I_D, I_WGLU, I_BGLU, I_WSSM, I_WATT, I_WO };

__device__ __forceinline__ void p0_transpose_item(const float* W, int N, bf16_t* WT, int ldt, int koff, LAS float* scr, int item, int lane) {
    const int nblk = N / 64, kb = item / nblk, nb = item % nblk, k0 = 64 * kb, n0 = 64 * nb;
    const int c16 = lane & 15, r4 = lane >> 4;
    f32x4 v[16];
#pragma unroll
    for (int i = 0; i < 16; ++i) v[i] = *(const f32x4*)(W + (size_t)(k0 + 4 * i + r4) * N + n0 + 4 * c16);
#pragma unroll
    for (int i = 0; i < 16; ++i) { LAS float* d = scr + (4 * i + r4) * 65 + 4 * c16; d[0] = v[i][0]; d[1] = v[i][1]; d[2] = v[i][2]; d[3] = v[i][3]; }
    LDS_WAIT(); asm volatile("" ::: "memory");
    const int c = lane & 7;
#pragma unroll
    for (int j = 0; j < 8; ++j) { const int n = (lane >> 3) + 8 * j; const LAS float* sp = scr + (8 * c) * 65 + n;
        u32x4 o; o.x = cvtpk(sp[0 * 65], sp[1 * 65]); o.y = cvtpk(sp[2 * 65], sp[3 * 65]); o.z = cvtpk(sp[4 * 65], sp[5 * 65]); o.w = cvtpk(sp[6 * 65], sp[7 * 65]);
        *(u32x4*)(WT + (size_t)(n0 + n) * ldt + koff + k0 + 8 * c) = o; }
    LDS_WAIT(); asm volatile("" ::: "memory");
}

__device__ __forceinline__ void p0_ssm_prep(KP A, LAS float* sc, int g, int qt, int tid) {
    LAS float* LPr = sc;
    LAS float* LPi = sc + 2176;
    LAS float* BBr = sc + 4352;
    LAS float* BBi = sc + 6400;
    LAS float* CCr = sc + 8448;
    LAS float* CCi = sc + 10496;
    LAS float* KT = sc + 12544;
    LAS float* COr = sc + 14592;
    LAS float* COi = sc + 14720;
    const float* a_re = A->in[I_ARE]; const float* a_im = A->in[I_AIM]; const float* logdt = A->in[I_LOGDT];
    {
        const int d = (tid >> 6) & 1, p = tid & 63, slot = tid >> 7;
        const float are = __builtin_fminf(a_re[(d * 64 + g) * 64 + p], -1e-4f), aim = a_im[(d * 64 + g) * 64 + p];
        const float dt = __expf(logdt[d * 64 + g]);
        const float zr = are * dt, zi = aim * dt;
#pragma unroll 1
        for (int e = slot; e <= 16; e += 4) { float sn, cn; sincos_rad((float)e * zi, sn, cn); const float mg = __expf((float)e * zr); LPr[(d * 17 + e) * 64 + p] = mg * cn; LPi[(d * 17 + e) * 64 + p] = mg * sn; }
        if (slot == 0) {
            float s1, c1, sh, chh; sincos_rad(zi, s1, c1); sincos_rad(0.5f * zi, sh, chh); (void)chh;
            const float em1 = expm1f(zr), mg = em1 + 1.0f;
            const float nr = em1 * c1 - 2.0f * sh * sh, ni = mg * s1;
            const float den = 1.0f / (are * are + aim * aim);
            COr[d * 64 + p] = (nr * are + ni * aim) * den; COi[d * 64 + p] = (ni * are - nr * aim) * den;
        }
    }
    __syncthreads();
    {
        const float* b_re = A->in[I_BRE]; const float* b_im = A->in[I_BIM]; const float* c_re = A->in[I_CRE]; const float* c_im = A->in[I_CIM];
#pragma unroll
        for (int n = 0; n < 4; ++n) { const int idx = tid + 512 * n, d = idx >> 10, p = (idx >> 4) & 63;
            const float br = b_re[((size_t)(d * 64 + g) * 64) * 16 + (idx & 1023)], bi = b_im[((size_t)(d * 64 + g) * 64) * 16 + (idx & 1023)];
            const float cr = COr[d * 64 + p], ci = COi[d * 64 + p];
            BBr[idx] = cr * br - ci * bi; BBi[idx] = cr * bi + ci * br; }
#pragma unroll
        for (int n = 0; n < 4; ++n) { const int idx = tid + 512 * n, d = idx >> 10, i = (idx >> 6) & 15, p = idx & 63;
            CCr[(d * 64 + p) * 16 + i] = c_re[((size_t)(d * 64 + g) * 16 + i) * 64 + p]; CCi[(d * 64 + p) * 16 + i] = c_im[((size_t)(d * 64 + g) * 16 + i) * 64 + p]; }
    }
    __syncthreads();
    {
        const int d = tid >> 8, dloc = (tid >> 6) & 3, i = (tid >> 2) & 15, jq = tid & 3, dl = 4 * qt + dloc;
        f32x4 acc = {0.f, 0.f, 0.f, 0.f};
#pragma unroll 4
        for (int p = 0; p < 64; ++p) {
            const float cr = CCr[(d * 64 + p) * 16 + i], ci = CCi[(d * 64 + p) * 16 + i], lr = LPr[(d * 17 + dl) * 64 + p], li = LPi[(d * 17 + dl) * 64 + p];
            const float tr = cr * lr - ci * li, ti = cr * li + ci * lr;
            const f32x4 br = *(const LAS f32x4*)(BBr + (d * 64 + p) * 16 + 4 * jq), bi = *(const LAS f32x4*)(BBi + (d * 64 + p) * 16 + 4 * jq);
            acc += tr * br - ti * bi;
        }
        *(LAS f32x4*)(KT + (d * 4 + dloc) * 256 + i * 16 + 4 * jq) = acc;
    }
    __syncthreads();
    bf16_t* WA = (bf16_t*)(A->ws + WS_WA) + (size_t)g * 256 * 256;
    bf16_t* WOS = (bf16_t*)(A->ws + WS_WOS) + (size_t)g * 256 * 512;
#pragma unroll 1
    for (int it = 0; it < 4; ++it) {
        const int q = it * 512 + tid, n = 64 * qt + (q >> 5), s = (q >> 1) & 15, jh = q & 1, d = n >> 7, ri = (n >> 6) & 1, p = n & 63;
        const int e = (d == 0) ? 15 - s : s;
        const float lr = LPr[(d * 17 + e) * 64 + p], li = LPi[(d * 17 + e) * 64 + p];
        const f32x4 br0 = *(const LAS f32x4*)(BBr + (d * 64 + p) * 16 + jh * 8), br1 = *(const LAS f32x4*)(BBr + (d * 64 + p) * 16 + jh * 8 + 4);
        const f32x4 bi0 = *(const LAS f32x4*)(BBi + (d * 64 + p) * 16 + jh * 8), bi1 = *(const LAS f32x4*)(BBi + (d * 64 + p) * 16 + jh * 8 + 4);
        const f32x4 v0 = ri == 0 ? lr * br0 - li * bi0 : lr * bi0 + li * br0, v1 = ri == 0 ? lr * br1 - li * bi1 : lr * bi1 + li * br1;
        *(u32x4*)(WA + (size_t)n * 256 + s * 16 + jh * 8) = pack8(v0, v1);
    }
    const float* dsk = A->in[I_D];
#pragma unroll 1
    for (int it = 0; it < 8; ++it) {
        const int q = it * 512 + tid, n = q >> 4, sidx = (q >> 1) & 7, jh = q & 1, tau = n >> 4, i = n & 15;
        int s, dd, dloc;
        if (sidx < 4) { dloc = 3 - sidx; s = tau - 4 * qt - dloc; dd = 0; } else { dloc = sidx - 4; s = tau + 4 * qt + dloc; dd = 1; }
        const bool diag = (qt == 0 && dloc == 0);
        if (s < 0 || s > 15 || (diag && dd == 1)) continue;
        const LAS float* kp = KT + (dd * 4 + dloc) * 256 + i * 16 + jh * 8;
        f32x4 v0 = *(const LAS f32x4*)kp, v1 = *(const LAS f32x4*)(kp + 4);
        if (diag) { const LAS float* k2 = KT + (1 * 4 + 0) * 256 + i * 16 + jh * 8; v0 += *(const LAS f32x4*)k2; v1 += *(const LAS f32x4*)(k2 + 4);
            const float dv = dsk[g * 16 + i]; const int jj = i - jh * 8;
            if (jj >= 0 && jj < 4) v0[jj] += dv; else if (jj >= 4 && jj < 8) v1[jj - 4] += dv; }
        *(u32x4*)(WOS + (size_t)n * 512 + s * 16 + jh * 8) = pack8(v0, v1);
    }
#pragma unroll 1
    for (int it = 0; it < 4; ++it) {
        const int q = it * 512 + tid, n = 64 * qt + (q >> 5), pc = q & 31, tau = n >> 4, i = n & 15;
        const int kk = pc * 8, d = kk >> 7, ri = (kk >> 6) & 1, p0 = kk & 63, f = (d == 0) ? tau + 1 : 16 - tau;
        float v[8];
#pragma unroll
        for (int jj = 0; jj < 8; ++jj) { const int p = p0 + jj; const float cr = CCr[(d * 64 + p) * 16 + i], ci = CCi[(d * 64 + p) * 16 + i], lr = LPr[(d * 17 + f) * 64 + p], li = LPi[(d * 17 + f) * 64 + p];
            v[jj] = ri == 0 ? cr * lr - ci * li : -(cr * li + ci * lr); }
        u32x4 o; o.x = cvtpk(v[0], v[1]); o.y = cvtpk(v[2], v[3]); o.z = cvtpk(v[4], v[5]); o.w = cvtpk(v[6], v[7]);
        *(u32x4*)(WOS + (size_t)n * 512 + 256 + pc * 8) = o;
    }
    __syncthreads();
}

__device__ __forceinline__ void p0_gemv_strip(KP A, LAS float* sc, int s, int tid) {
    LAS float* cs = sc;
    LAS float* red = sc + 6144;
    const float* cctx = A->in[I_CCTX]; const float* c = A->in[I_C];
    for (int i = tid; i < 6144; i += 512) { const float v = (i < 2048) ? cctx[i] : c[i - 2048]; cs[i] = silu_f(v); }
    __syncthreads();
    const int wid = tid >> 6, lane = tid & 63, kk = lane >> 3, c4 = lane & 7;
    const float* W = A->in[I_WADA] + (size_t)(256 * wid + kk) * 6144 + 32 * s + 4 * c4;
    f32x4 a0 = {0.f, 0.f, 0.f, 0.f}, a1 = a0, a2 = a0;
#pragma unroll 32
    for (int it = 0; it < 32; ++it) { const f32x4 w = *(const f32x4*)(W + (size_t)it * 8 * 6144); const int k = 256 * wid + 8 * it + kk;
        a0 += cs[k] * w; a1 += cs[2048 + k] * w; a2 += cs[4096 + k] * w; }
#pragma unroll
    for (int e = 0; e < 4; ++e) {
#pragma unroll
        for (int o = 8; o < 64; o <<= 1) { a0[e] += __shfl_xor(a0[e], o); a1[e] += __shfl_xor(a1[e], o); a2[e] += __shfl_xor(a2[e], o); }
    }
    if (kk == 0) {
#pragma unroll
        for (int e = 0; e < 4; ++e) { red[(wid * 3 + 0) * 32 + c4 * 4 + e] = a0[e]; red[(wid * 3 + 1) * 32 + c4 * 4 + e] = a1[e]; red[(wid * 3 + 2) * 32 + c4 * 4 + e] = a2[e]; }
    }
    __syncthreads();
    if (tid < 96) { const int cnd = tid >> 5, col = tid & 31; float v = A->in[I_BADA][32 * s + col];
#pragma unroll
        for (int w = 0; w < 8; ++w) v += red[(w * 3 + cnd) * 32 + col];
        ((float*)(A->ws + WS_MOD))[cnd * 6144 + 32 * s + col] = v; }
    __syncthreads();
}

constexpr int CW_GEMV = 64, CW_ATT = 128, CW_SSM0 = 192, CW_SSM1 = 256;
__device__ __forceinline__ void phase1(KP A, int lane, int wave);
__device__ __forceinline__ void phase0(KP A, LAS unsigned char* lds, int tid, int lane, int wave) {
    const int bx = blockIdx.x, G = gridDim.x;
    unsigned* cnt = (unsigned*)(A->ws + WS_CTL) + CW_GEMV;
#ifndef SUBDUP
#define SUBDUP 0
#endif
    LAS float* scr = (LAS float*)(lds + wave * 16640);
    const int gw = bx * NWAVES + wave, NGW = G * NWAVES;
    constexpr int I_IN = 32 * 160, I_GLU = 16 * 16, I_SO = 16 * 32, I_AO = 16 * 32, I_O = 32 * 32, NITEMS = I_IN + I_GLU + I_SO + I_AO + I_O;
#pragma unroll 1
    for (int step = 0; step < 3; ++step) {
        const int what = (bx & 1) ? (step == 0 ? 2 : step - 1) : step;
        if (what == 0) {
            for (int t = bx; t < 192; t += G) {
                p0_gemv_strip(A, (LAS float*)lds, t, tid);
                VM_WAIT(); __syncthreads();
                if (tid == 0) { __builtin_amdgcn_fence(__ATOMIC_RELEASE, "agent"); VM_WAIT(); __hip_atomic_fetch_add(cnt, 1u, __ATOMIC_RELAXED, __HIP_MEMORY_SCOPE_AGENT); }
            }
        } else if (what == 1) {
            __syncthreads();
            for (int it = gw; it < NITEMS; it += NGW) {
                int r = it;
                if (r < I_IN) { p0_transpose_item(A->in[I_WIN], INW, (bf16_t*)(A->ws + WS_WIN), 2048, 0, scr, r, lane); continue; } r -= I_IN;
                if (r < I_GLU) { p0_transpose_item(A->in[I_WGLU], 1024, (bf16_t*)(A->ws + WS_WGLU), 1024, 0, scr, r, lane); continue; } r -= I_GLU;
                if (r < I_SO) { p0_transpose_item(A->in[I_WSSM], 2048, (bf16_t*)(A->ws + WS_WM), 2048, 0, scr, r, lane); continue; } r -= I_SO;
                if (r < I_AO) { p0_transpose_item(A->in[I_WATT], 2048, (bf16_t*)(A->ws + WS_WM), 2048, 1024, scr, r, lane); continue; } r -= I_AO;
                p0_transpose_item(A->in[I_WO], 2048, (bf16_t*)(A->ws + WS_WO), 2048, 0, scr, r, lane);
            }
            __syncthreads();
        } else {
            for (int t = bx; t < 256; t += G) p0_ssm_prep(A, (LAS float*)lds, t >> 2, t & 3, tid);
        }
    }
    {
        const int gt = bx * 512 + tid, NT = G * 512;
        for (int i = gt; i < 2 * 131072; i += NT) {
            const int which = i >> 17, j = i & 131071;
            const float* src = A->in[which ? I_CV : I_CK] + (size_t)j * 8;
            const f32x4 a = *(const f32x4*)src, b = *(const f32x4*)(src + 4);
            const int row = j >> 7, hh = (j >> 3) & 15, d0 = (j & 7) * 8;
            const size_t img = (size_t)((row >> 6) * 16 + hh) * 4096;
            const size_t off = which ? img + ((d0 >> 5) * 4 + ((row & 63) >> 4)) * 512 + (row & 15) * 32 + ((d0 & 31) >> 3) * 8 : img + (d0 >> 3) * 512 + (row & 63) * 8;
            *(u32x4*)((bf16_t*)(A->ws + (which ? WS_CV : WS_CK)) + off) = pack8(a, b);
        }
    }
    if (tid == 0) {
        unsigned sp = 0;
        while (__hip_atomic_load(cnt, __ATOMIC_RELAXED, __HIP_MEMORY_SCOPE_AGENT) < 192u) { __builtin_amdgcn_s_sleep(2); if (++sp > (1u << 22)) break; }
        __builtin_amdgcn_fence(__ATOMIC_ACQUIRE, "agent");
        VM_WAIT();
    }
    __syncthreads();
    _Pragma("unroll 1") for (int sd_ = 0; sd_ < 1 + ((SUBDUP >> 3) & 1); ++sd_)
    phase1(A, lane, wave);
}

__device__ __forceinline__ void phase1(KP A, int lane, int wave) {
    const int gw = blockIdx.x * NWAVES + wave, NGW = gridDim.x * NWAVES;
    const float* mod = (const float*)(A->ws + WS_MOD); const float* nw = A->in[I_NORMW];
    bf16_t* XN = (bf16_t*)(A->ws + WS_XN);
    for (int m = gw; m < NTOK; m += NGW) {
        const float* xr = (m < NPROMPT) ? A->in[I_XP] + (size_t)m * 2048 : A->in[I_XS] + (size_t)(m - NPROMPT) * 2048;
        const int cond = (m < NPROMPT) ? 0 : 1 + ((m - NPROMPT) >> 11);
        const float* sh = mod + cond * 6144; const float* scl = sh + 2048;
        f32x4 v[8]; float s = 0.f;
#pragma unroll
        for (int j = 0; j < 8; ++j) { v[j] = *(const f32x4*)(xr + 4 * lane + 256 * j); s += (v[j][0] * v[j][0] + v[j][1] * v[j][1]) + (v[j][2] * v[j][2] + v[j][3] * v[j][3]); }
        const float rstd = __builtin_amdgcn_rsqf(wave_sum(s) * (1.0f / 2048.0f) + EPSN);
#pragma unroll
        for (int j = 0; j < 8; ++j) { const int c = 4 * lane + 256 * j; const f32x4 w = *(const f32x4*)(nw + c), a = *(const f32x4*)(scl + c), b = *(const f32x4*)(sh + c);
            const f32x4 o = (v[j] * rstd * w) * (a + 1.0f) + b; u32x2 pk; pk.x = cvtpk(o[0], o[1]); pk.y = cvtpk(o[2], o[3]);
            *(u32x2*)(XN + (size_t)m * 2048 + c) = pk; }
    }
}

__device__ __forceinline__ void ssm_scan_unit(KP A, LAS unsigned char* lds, int L, int tid) {
    const int g = L >> 1, hf = L & 1;
    const int p = tid & 63, d = (tid >> 6) & 1, sq = tid >> 7;
    LAS float* El = (LAS float*)lds;
    LAS float* Cl = (LAS float*)(lds + 16384);
    const float are = __builtin_fminf(A->in[I_ARE][(d * 64 + g) * 64 + p], -1e-4f), aim = A->in[I_AIM][(d * 64 + g) * 64 + p];
    const float dt = __expf(A->in[I_LOGDT][d * 64 + g]);
    float ls, lc; sincos_rad(16.0f * aim * dt, ls, lc); const float mg = __expf(16.0f * are * dt);
    const float lr = mg * lc, li = mg * ls;
    const float* S = (const float*)(A->ws + WS_S) + (size_t)L * 256 * 256 + d * 128 + p;
    float sr[4][16], si[4][16];
#pragma unroll
    for (int k = 0; k < 4; ++k)
#pragma unroll
        for (int j = 0; j < 16; ++j) { const int row = (sq + 4 * k) * 16 + j; sr[k][j] = S[(size_t)row * 256]; si[k][j] = S[(size_t)row * 256 + 64]; }
    if (hf) {
#pragma unroll
        for (int k = 0; k < 4; ++k) { float er = 0.f, ei = 0.f;
#pragma unroll
            for (int jj = 0; jj < 16; ++jj) { const int j = d ? 15 - jj : jj; const float nr = lr * er - li * ei + sr[k][j], ni = lr * ei + li * er + si[k][j]; er = nr; ei = ni; }
            const int sg = sq + 4 * k; El[(sg * 128 + d * 64 + p) * 2] = er; El[(sg * 128 + d * 64 + p) * 2 + 1] = ei; }
        __syncthreads();
        if (tid < 256) {
            const int sb = tid >> 7;
            float l16r = lr, l16i = li;
#pragma unroll
            for (int q = 0; q < 4; ++q) { const float nr = l16r * l16r - l16i * l16i, ni = 2.0f * l16r * l16i; l16r = nr; l16i = ni; }
            float cr = A->in[I_SRE][((sb * 2 + d) * 64 + g) * 64 + p], ci = A->in[I_SIM][((sb * 2 + d) * 64 + g) * 64 + p];
#pragma unroll
            for (int q = 0; q < 8; ++q) { const int sg = sb * 8 + (d ? 7 - q : q); const int ix = (sg * 128 + d * 64 + p) * 2;
                Cl[ix] = cr; Cl[ix + 1] = ci; const float er = El[ix], ei = El[ix + 1];
                const float nr = l16r * cr - l16i * ci + er, ni = l16r * ci + l16i * cr + ei; cr = nr; ci = ni; }
        }
        __syncthreads();
    }
    bf16_t* H = (bf16_t*)(A->ws + WS_UH) + (size_t)L * 256 * 512 + 256 + d * 128 + p;
#pragma unroll
    for (int k = 0; k < 4; ++k) { const int sg = sq + 4 * k;
        float hr = 0.f, hi = 0.f;
        if (hf) { hr = Cl[(sg * 128 + d * 64 + p) * 2]; hi = Cl[(sg * 128 + d * 64 + p) * 2 + 1]; }
#pragma unroll
        for (int jj = 0; jj < 16; ++jj) { const int j = d ? 15 - jj : jj; const size_t row = (size_t)(sg * 16 + j);
            H[row * 512] = (bf16_t)(cvtpk(hr, 0.f) & 0xffffu); H[row * 512 + 64] = (bf16_t)(cvtpk(hi, 0.f) & 0xffffu);
            const float nr = lr * hr - li * hi + sr[k][j], ni = lr * hi + li * hr + si[k][j]; hr = nr; hi = ni; }
        if (!hf) { A->out[OUT_SRE + ((size_t)(sg * 2 + d) * 64 + g) * 64 + p] = hr; A->out[OUT_SIM + ((size_t)(sg * 2 + d) * 64 + g) * 64 + p] = hi; }
    }
}

namespace att {
constexpr int NSLOT = 4, SLOT = 16384;
constexpr int RING = 0, WSF = 65536, STG = 67584, BIAS = 100352;
constexpr float THR = 8.0f;
__device__ __forceinline__ int crow(int r, int hi) { return (r & 3) + 8 * (r >> 2) + 4 * hi; }
__device__ __forceinline__ constexpr int ccol(int r) { return (r & 3) + 8 * (r >> 2); }
__device__ __forceinline__ s16x4 vtr(const LAS unsigned char* p) { return __builtin_bit_cast(s16x4, __builtin_amdgcn_ds_read_tr16_b64_v4i16((LAS s16x4*)p)); }
#define MX3(a, b, c) __builtin_fmaxf(__builtin_fmaxf((a), (b)), (c))

template <int MODE>
__device__ __forceinline__ void tile(const LAS unsigned char* slot, const bf16x8 (&qr)[4], f32x16& negm, float& mhat, float& lrun, f32x16& o0, f32x16& o1,
                                     LAS float* wsf, const LAS float* brow, const float (&m20)[20], int r32, int hi, int lane, bool first) {
    constexpr int P0_LO = (MODE == 2) ? 12 : 0, P1_HI = (MODE == 1) ? 4 : 16;
    f32x16 p0, p1;
    { const LAS unsigned char* kb = slot + hi * 1024 + r32 * 16;
#pragma unroll
      for (int d0 = 0; d0 < 4; ++d0) { const bf16x8 b0 = *(const LAS bf16x8*)(kb + d0 * 2048), b1 = *(const LAS bf16x8*)(kb + d0 * 2048 + 512);
          if (d0 == 0) { p0 = __builtin_amdgcn_mfma_f32_32x32x16_bf16(b0, qr[0], negm, 0, 0, 0); p1 = __builtin_amdgcn_mfma_f32_32x32x16_bf16(b1, qr[0], negm, 0, 0, 0); }
          else { p0 = __builtin_amdgcn_mfma_f32_32x32x16_bf16(b0, qr[d0], p0, 0, 0, 0); p1 = __builtin_amdgcn_mfma_f32_32x32x16_bf16(b1, qr[d0], p1, 0, 0, 0); } } }
    if (MODE != 0) {
#pragma unroll
        for (int rr = P0_LO; rr < 16; ++rr) p0[rr] += brow[ccol(rr)] + m20[MODE == 1 ? rr : rr - 12];
#pragma unroll
        for (int rr = 0; rr < P1_HI; ++rr) p1[rr] += brow[32 + ccol(rr)] + m20[MODE == 1 ? 16 + rr : 4 + rr];
    }
    float ra, rb;
    if (MODE == 0) { ra = MX3(p0[0], p0[1], p1[0]); rb = MX3(p0[2], p0[3], p1[1]); ra = MX3(ra, p1[2], p1[3]);
#pragma unroll
        for (int r = 4; r < 16; r += 4) { ra = MX3(ra, p0[r], p0[r + 1]); rb = MX3(rb, p0[r + 2], p0[r + 3]); ra = MX3(ra, p1[r], p1[r + 1]); rb = MX3(rb, p1[r + 2], p1[r + 3]); } }
    else if (MODE == 1) { ra = MX3(p0[0], p0[1], p1[0]); rb = MX3(p0[2], p0[3], p1[1]); ra = MX3(ra, p1[2], p1[3]);
#pragma unroll
        for (int r = 4; r < 16; r += 4) { ra = MX3(ra, p0[r], p0[r + 1]); rb = MX3(rb, p0[r + 2], p0[r + 3]); } }
    else { ra = MX3(p1[0], p1[1], p0[12]); rb = MX3(p1[2], p1[3], p0[13]); ra = MX3(ra, p0[14], p0[15]);
#pragma unroll
        for (int r = 4; r < 16; r += 4) { ra = MX3(ra, p1[r], p1[r + 1]); rb = MX3(rb, p1[r + 2], p1[r + 3]); } }
    float rm = __builtin_fmaxf(ra, rb);
    rm = __builtin_fmaxf(rm, __shfl_xor(rm, 32));
    if (first || __any(rm > THR)) {
        const float dl = first ? rm : __builtin_fmaxf(rm, 0.f);
        mhat += dl;
#pragma unroll
        for (int rr = P0_LO; rr < 16; ++rr) p0[rr] -= dl;
#pragma unroll
        for (int rr = 0; rr < P1_HI; ++rr) p1[rr] -= dl;
#pragma unroll
        for (int rr = 0; rr < 16; ++rr) negm[rr] = -mhat;
        const float f = __builtin_amdgcn_exp2f(-dl);
        lrun *= f;
        if (hi == 0) wsf[r32] = f;
        LDS_WAIT();
#pragma unroll
        for (int rr = 0; rr < 16; ++rr) { const float ff = wsf[crow(rr, hi)]; o0[rr] *= ff; o1[rr] *= ff; }
    }
    float sa = 0.f, sb = 0.f;
#pragma unroll
    for (int rr = P0_LO; rr < 16; rr += 2) { p0[rr] = __builtin_amdgcn_exp2f(p0[rr]); p0[rr + 1] = __builtin_amdgcn_exp2f(p0[rr + 1]); sa += p0[rr]; sb += p0[rr + 1]; }
#pragma unroll
    for (int rr = 0; rr < P1_HI; rr += 2) { p1[rr] = __builtin_amdgcn_exp2f(p1[rr]); p1[rr + 1] = __builtin_amdgcn_exp2f(p1[rr + 1]); sa += p1[rr]; sb += p1[rr + 1]; }
    lrun += sa + sb;
    u32x4 pw[4];
    if (MODE == 2) { pw[0] = (u32x4){0u, 0u, 0u, 0u}; pw[1] = (u32x4){0u, 0u, cvtpk(p0[12], p0[13]), cvtpk(p0[14], p0[15])}; }
    else { pw[0] = (u32x4){cvtpk(p0[0], p0[1]), cvtpk(p0[2], p0[3]), cvtpk(p0[4], p0[5]), cvtpk(p0[6], p0[7])};
           pw[1] = (u32x4){cvtpk(p0[8], p0[9]), cvtpk(p0[10], p0[11]), cvtpk(p0[12], p0[13]), cvtpk(p0[14], p0[15])}; }
    if (MODE == 1) { pw[2] = (u32x4){cvtpk(p1[0], p1[1]), cvtpk(p1[2], p1[3]), 0u, 0u}; pw[3] = (u32x4){0u, 0u, 0u, 0u}; }
    else { pw[2] = (u32x4){cvtpk(p1[0], p1[1]), cvtpk(p1[2], p1[3]), cvtpk(p1[4], p1[5]), cvtpk(p1[6], p1[7])};
           pw[3] = (u32x4){cvtpk(p1[8], p1[9]), cvtpk(p1[10], p1[11]), cvtpk(p1[12], p1[13]), cvtpk(p1[14], p1[15])}; }
    const LAS unsigned char* vp = slot + 8192 + ((lane >> 4) & 1) * 32 + (lane & 3) * 8 + (4 * hi + ((lane & 15) >> 2)) * 64;
    constexpr int K_LO = (MODE == 2) ? 1 : 0, K_HI = (MODE == 1) ? 3 : 4;
#pragma unroll
    for (int k = K_LO; k < K_HI; ++k) {
        const s16x4 l0 = vtr(vp + k * 1024), h0 = vtr(vp + k * 1024 + 512), l1 = vtr(vp + 4096 + k * 1024), h1 = vtr(vp + 4096 + k * 1024 + 512);
        const bf16x8 v0 = (bf16x8){l0[0], l0[1], l0[2], l0[3], h0[0], h0[1], h0[2], h0[3]}, v1 = (bf16x8){l1[0], l1[1], l1[2], l1[3], h1[0], h1[1], h1[2], h1[3]};
        const bf16x8 pa = __builtin_bit_cast(bf16x8, pw[k]);
        o0 = __builtin_amdgcn_mfma_f32_32x32x16_bf16(pa, v0, o0, 0, 0, 0); o1 = __builtin_amdgcn_mfma_f32_32x32x16_bf16(pa, v1, o1, 0, 0, 0);
    }
}

template <bool NA>
__device__ __forceinline__ void unit(KP A, LAS unsigned char* lds, int un, int tid_in) {
    int tid = tid_in; asm volatile("" : "+v"(tid));
    const int lane = tid & 63, r32 = lane & 31, hi = lane >> 5, wid = __builtin_amdgcn_readfirstlane(tid >> 6);
    const bf16_t* Q = (const bf16_t*)(A->ws + WS_Q); const bf16_t* KBp = (const bf16_t*)(A->ws + WS_KB); const bf16_t* VBp = (const bf16_t*)(A->ws + WS_VB);
    const bf16_t* CK = (const bf16_t*)(A->ws + WS_CK); const bf16_t* CV = (const bf16_t*)(A->ws + WS_CV);
    int b, h, NT, qtok0, r = 0, rs = 0, rlo = 0, half = 0;
    if (NA) { b = un >> 7; h = (un >> 3) & 15; const int R4 = un & 7; r = 4 * R4 + (wid >> 1); half = wid & 1; qtok0 = NPROMPT + b * 2048 + r * 64 + half * 32;
        rs = min(max(r - 4, 0), 24); rlo = min(max(4 * R4 - 4, 0), 24); const int rhi = min(max(4 * R4 - 1, 0), 24) + 7; NT = 8 + (rhi - rlo + 1); }
    else { b = un >> 4; h = un & 15; qtok0 = b * 256 + wid * 32; NT = 4; }
    LAS float* wsf = (LAS float*)(lds + WSF) + wid * 64;
    LAS float* bl = (LAS float*)(lds + BIAS);
    const int qc = half * 32 + r32, cs = min(max(qc - 8, 0), 48);
    float m20[20];
    if (NA) {
#pragma unroll
        for (int e = 0; e < 20; ++e) {
            const int rr0 = (e < 16) ? e : e - 16, kc0 = ccol(rr0) + ((e < 16) ? 0 : 32);
            const int rr1 = (e < 4) ? 12 + e : e - 4, kc1 = ccol(rr1) + ((e < 4) ? 0 : 32);
            const int kc = (half ? kc1 : kc0) + 4 * hi;
            m20[e] = (kc >= cs && kc < cs + 16) ? 0.f : -1e30f;
        }
    } else {
#pragma unroll
        for (int e = 0; e < 20; ++e) m20[e] = 0.f;
    }
    const int koff = wid * 512 + lane * 8, voff = koff;
    auto issue = [&](int tt, int sl) {
        const bf16_t *kb, *vb;
        if (NA) { if (tt < 8) { const size_t o = (size_t)((b * 8 + tt) * 16 + h) * 4096; kb = CK + o; vb = CV + o; }
                  else { const size_t o = (size_t)((64 + b * 32 + rlo + tt - 8) * 16 + h) * 4096; kb = KBp + o; vb = VBp + o; } }
        else { const size_t o = (size_t)((b * 4 + tt) * 16 + h) * 4096; kb = KBp + o; vb = VBp + o; }
        const int so = RING + (sl & 3) * SLOT + wid * 1024;
        __builtin_amdgcn_global_load_lds((const unsigned*)(kb + koff), (LAS unsigned*)(lds + so), 16, 0, 0);
        __builtin_amdgcn_global_load_lds((const unsigned*)(vb + voff), (LAS unsigned*)(lds + so + 8192), 16, 0, 0);
    };
    issue(0, 0); issue(1, 1); issue(2, 2);
    if (NA) { for (int i = tid; i < 640; i += 512) bl[i] = (i >= 64 && i < 529) ? A->in[I_RPB][h * 465 + i - 64] * LOG2E : 0.f; }
    bf16x8 qr[4];
    { const bf16_t* qp = Q + (size_t)(qtok0 + r32) * 1024 + h * 64 + hi * 8;
#pragma unroll
      for (int d0 = 0; d0 < 4; ++d0) qr[d0] = *(const bf16x8*)(qp + d0 * 16); }
    asm volatile("s_waitcnt vmcnt(0)" : "+v"(qr[0]), "+v"(qr[1]), "+v"(qr[2]), "+v"(qr[3]) :: "memory");
    float mhat = 0.f, lrun = 0.f; f32x16 o0 = {}, o1 = {}, negm = {};
    const int lb = 64 + 4 * hi - qc + 15;
#pragma unroll 1
    for (int t = 0; t < NT; ++t) {
        asm volatile("s_waitcnt vmcnt(4)" ::: "memory");
        __builtin_amdgcn_s_barrier(); asm volatile("" ::: "memory");
        issue(min(t + 3, NT - 1), t + 3);
        const int kr = rlo + t - 8;
        const LAS unsigned char* slot = lds + RING + (t & 3) * SLOT;
        if (!NA || t < 8) tile<0>(slot, qr, negm, mhat, lrun, o0, o1, wsf, bl, m20, r32, hi, lane, t == 0);
        else if (kr >= rs && kr < rs + 8) {
            const LAS float* brow = bl + (kr - r + 7) * 31 + lb;
            if (half == 0) tile<1>(slot, qr, negm, mhat, lrun, o0, o1, wsf, brow, m20, r32, hi, lane, false);
            else tile<2>(slot, qr, negm, mhat, lrun, o0, o1, wsf, brow, m20, r32, hi, lane, false);
        }
    }
    asm volatile("s_waitcnt vmcnt(0)" ::: "memory");
    const bf16_t* ZA = (const bf16_t*)(A->ws + WS_ZA); bf16_t* A2 = (bf16_t*)(A->ws + WS_A2);
    const float ltot = lrun + __shfl_xor(lrun, 32);
    if (hi == 0) wsf[32 + r32] = ltot;
    LDS_WAIT();
    LAS bf16_t* stg = (LAS bf16_t*)(lds + STG) + wid * 2048;
#pragma unroll
    for (int rr = 0; rr < 16; ++rr) { const int orow = crow(rr, hi); const float rl = __builtin_amdgcn_rcpf(wsf[32 + orow]);
        stg[orow * 64 + r32] = (bf16_t)(cvtpk(o0[rr] * rl, 0.f) & 0xffffu); stg[orow * 64 + 32 + r32] = (bf16_t)(cvtpk(o1[rr] * rl, 0.f) & 0xffffu); }
    LDS_WAIT();
#pragma unroll
    for (int i = 0; i < 4; ++i) { const int row = i * 8 + (lane >> 3), ch = lane & 7; const u32x4 ov = *(const LAS u32x4*)(stg + row * 64 + ch * 8);
        const size_t tok = (size_t)(qtok0 + row);
        f32x4 a0, a1, z0, z1; unpack8(ov, a0, a1); unpack8(*(const u32x4*)(ZA + tok * 1024 + h * 64 + ch * 8), z0, z1);
        *(u32x4*)(A2 + tok * 2048 + 1024 + h * 64 + ch * 8) = pack8(a0 * z0, a1 * z1); }
    __syncthreads();
}
#undef MX3
}

constexpr int NPHASE = 9;
__device__ __forceinline__ int opaque_i(int v) { asm volatile("" : "+s"(v)); return v; }
__global__ void __launch_bounds__(NWAVES * 64, 2) fwd_kernel(Args args_unused) {
    KP args = fresh_kp();
    extern __shared__ __attribute__((aligned(16))) unsigned char lds_raw[];
    LAS unsigned char* lds = (LAS unsigned char*)lds_raw;
    volatile LAS unsigned* MISC = (volatile LAS unsigned*)(lds + MISC_OFF);
    const int tid = threadIdx.x, lane = tid & 63, wave = __builtin_amdgcn_readfirstlane(tid >> 6);
    const int G = gridDim.x;
    for (int u = tid; u < (LDS_BYTES - MISC_OFF) / 4; u += NWAVES * 64) ((LAS unsigned*)(lds + MISC_OFF))[u] = 0u;
    __syncthreads();
    unsigned* barw = (unsigned*)(args->ws + WS_CTL) + 4096;
    const int lo = args->ph_lo, hi = args->ph_hi;
    const bool one = (hi - lo) > 1;
    XcdBarrier bar; bar.bar = barw; bar.x = 0; bar.st = nullptr;
    if (one) bar = xcd_barrier_post(barw, MISC + 8);
#ifndef PHMASK
#define PHMASK 0x1ff
#endif
#define IN(k) (((PHMASK >> (k)) & 1) && lo <= (k) && (k) < hi)
#ifndef DUPMASK
#define DUPMASK 0
#endif
#define REP(k) _Pragma("unroll 1") for (int rep_ = 0; rep_ < 1 + ((DUPMASK >> (k)) & 1); ++rep_)
#define NREP(k) (1 + ((DUPMASK >> (k)) & 1))
#ifndef TS_A
#define TS_A -2
#define TS_B -2
#endif
    unsigned long long* stamps = (unsigned long long*)(args->ws + WS_CTL + 2048);
    int n_stamp = 0;
#define STAMP() do { if (TS_A >= -1 && blockIdx.x == 0 && tid == 0) stamps[n_stamp] = __builtin_amdgcn_s_memrealtime(); ++n_stamp; } while (0)
    STAMP();
#define SEAM(k) do { if (IN(k) && IN((k) + 1)) xcd_barrier(bar); STAMP(); } while (0)

    if (IN(0)) { KP kp = fresh_kp(); REP(0) phase0(kp, lds, tid, lane, wave); if (IN(2)) xcd_barrier(bar); STAMP(); }
    if (IN(2)) {
        KP kp = fresh_kp(); unsigned char* ws = kp->ws;
        pg8::Gemm g{(const bf16_t*)(ws + WS_XN), (const bf16_t*)(ws + WS_WIN), 2048, 2048, 2048};
        pg8::StaticOrder S; S.init(32, 40, G, (int)blockIdx.x, NREP(2));
        EpiIn E{(bf16_t*)(ws + WS_UH), (bf16_t*)(ws + WS_ZS), (bf16_t*)(ws + WS_Q), (bf16_t*)(ws + WS_KB), (bf16_t*)(ws + WS_VB), (bf16_t*)(ws + WS_ZA), (bf16_t*)(ws + WS_GS), (bf16_t*)(ws + WS_GA),
                kp->out + OUT_CK, kp->out + OUT_CV, kp->in[I_QNW], kp->in[I_KNW], (LAS float*)(lds + XCH_OFF)};
        pg8::gemm_phase<EpiIn, pg8::StaticOrder, true>(lds, g, S, E);
        SEAM(2);
    }
    if (IN(3)) {
        unsigned* ctl = (unsigned*)(fresh_kp()->ws + WS_CTL);
        if (blockIdx.x < 128) {
            KP kp = fresh_kp(); unsigned char* ws = kp->ws; const int L = blockIdx.x;
            { pg8::Gemm g{(const bf16_t*)(ws + WS_UH), (const bf16_t*)(ws + WS_WA), 512, 256, 256}; pg8::OneUnit S{L, L >> 1}; EpiS E{(float*)(ws + WS_S)};
              pg8::gemm_phase<EpiS, pg8::OneUnit, false>(lds, g, S, E); }
            VM_WAIT(); __syncthreads();
            ssm_scan_unit(kp, lds, L, tid);
            VM_WAIT(); __syncthreads();
            { pg8::Gemm g{(const bf16_t*)(ws + WS_UH), (const bf16_t*)(ws + WS_WOS), 512, 512, 512}; pg8::OneUnit S{L, L >> 1}; EpiY E{(bf16_t*)(ws + WS_YS)};
              pg8::gemm_phase<EpiY, pg8::OneUnit, false>(lds, g, S, E); }
            VM_WAIT(); __syncthreads();
            if (tid == 0) __hip_atomic_fetch_add(ctl + ((L & 1) ? CW_SSM1 : CW_SSM0), 1u, __ATOMIC_RELAXED, __HIP_MEMORY_SCOPE_AGENT);
        }
        STAMP();
        unsigned nxt = 0u;
        if (tid == 0) nxt = __hip_atomic_fetch_add(ctl + CW_ATT, 1u, __ATOMIC_RELAXED, __HIP_MEMORY_SCOPE_AGENT);
        for (;;) {
            KP kp = fresh_kp();
            __syncthreads();
            if (tid == 0) MISC[16] = nxt;
            __syncthreads();
            const int un = (int)MISC[16];
            if (un >= 640) break;
            if (tid == 0) nxt = __hip_atomic_fetch_add(ctl + CW_ATT, 1u, __ATOMIC_RELAXED, __HIP_MEMORY_SCOPE_AGENT);
            if (un < 256) att::unit<true>(kp, lds, un, tid);
            else if (un < 384) {
                const int gu = un - 256, pm = gu >> 2, pn = gu & 3;
                if (tid == 0) {
                    unsigned* c = ctl + (pm < 16 ? CW_SSM0 : CW_SSM1); unsigned sp = 0;
                    while (__hip_atomic_load(c, __ATOMIC_RELAXED, __HIP_MEMORY_SCOPE_AGENT) < 64u) { __builtin_amdgcn_s_sleep(4); if (++sp > (1u << 22)) break; }
                    __builtin_amdgcn_fence(__ATOMIC_ACQUIRE, "agent"); VM_WAIT();
                }
                __syncthreads();
                unsigned char* ws = kp->ws;
                pg8::Gemm g{(const bf16_t*)(ws + WS_YS), (const bf16_t*)(ws + WS_WGLU), 1024, 1024, 1024}; pg8::OneUnit S{pm, pn};
                EpiGlu E{(const bf16_t*)(ws + WS_YS), (const bf16_t*)(ws + WS_ZS), kp->in[I_BGLU], (bf16_t*)(ws + WS_A2)};
                pg8::gemm_phase<EpiGlu, pg8::OneUnit, false>(lds, g, S, E);
            }
            else att::unit<false>(kp, lds, un - 384, tid);
        }
        SEAM(3);
    }
    if (IN(7)) {
        KP kp = fresh_kp(); unsigned char* ws = kp->ws;
        pg8::Gemm g{(const bf16_t*)(ws + WS_A2), (const bf16_t*)(ws + WS_WM), 2048, 2048, 2048};
        pg8::StaticOrder S; S.init(32, 8, G, (int)blockIdx.x, NREP(7));
        EpiMerge E{(const bf16_t*)(ws + WS_GS), (const bf16_t*)(ws + WS_GA), (bf16_t*)(ws + WS_MG)};
        pg8::gemm_phase<EpiMerge, pg8::StaticOrder, false>(lds, g, S, E);
        SEAM(7);
    }
    if (IN(8)) {
        KP kp = fresh_kp(); unsigned char* ws = kp->ws;
        pg8::Gemm g{(const bf16_t*)(ws + WS_MG), (const bf16_t*)(ws + WS_WO), 2048, 2048, 2048};
        pg8::StaticOrder S; S.init(32, 8, G, (int)blockIdx.x, NREP(8));
        EpiOut E{kp->in[I_XP], kp->in[I_XS], (const float*)(ws + WS_MOD), kp->out + OUT_Y};
        pg8::gemm_phase<EpiOut, pg8::StaticOrder, false>(lds, g, S, E);
    }
    STAMP();
    if (TS_A >= -1 && blockIdx.x == 0) {
        VM_WAIT(); __syncthreads();
        float t_us = 200.0f;
        if (TS_A >= 0) { const unsigned long long a = __hip_atomic_load(stamps + (TS_A < 0 ? 0 : TS_A), __ATOMIC_RELAXED, __HIP_MEMORY_SCOPE_AGENT), b = __hip_atomic_load(stamps + (TS_B < 0 ? 0 : TS_B), __ATOMIC_RELAXED, __HIP_MEMORY_SCOPE_AGENT); t_us = (float)(long long)(b - a) * 0.01f; }
        const float eps = __builtin_sqrtf(__builtin_fmaxf(t_us, 0.f) * 2e-7f);
        KP kp = fresh_kp(); float* o = kp->out + OUT_SIM;
        for (int i = tid; i < 131072; i += 512) o[i] = o[i] * (1.0f + eps);
    }
#undef IN
#undef SEAM
}

extern "C" void kernel_launch(void* const* d_in, const int* in_sizes, int n_in, void* d_out, int out_size, void* d_ws, size_t ws_size, hipStream_t stream) {
    static int grid = 0;
    if (grid == 0) {
        if (n_in != 28 || out_size != (int)OUT_TOTAL || ws_size < WS_END) { fprintf(stderr, "kernel_launch: unexpected problem (n_in %d, out %d, ws %zu)\n", n_in, out_size, ws_size); grid = -1; return; }
        int dev = 0, cus = 0, per_cu = 0;
        if (hipGetDevice(&dev) != hipSuccess || hipDeviceGetAttribute(&cus, hipDeviceAttributeMultiprocessorCount, dev) != hipSuccess) { grid = -1; return; }
        if (hipFuncSetAttribute((const void*)fwd_kernel, hipFuncAttributeMaxDynamicSharedMemorySize, LDS_BYTES) != hipSuccess) { fprintf(stderr, "kernel_launch: hipFuncSetAttribute failed\n"); grid = -1; return; }
        if (hipOccupancyMaxActiveBlocksPerMultiprocessor(&per_cu, (const void*)fwd_kernel, NWAVES * 64, LDS_BYTES) != hipSuccess || per_cu < 1) { fprintf(stderr, "kernel_launch: occupancy query says %d\n", per_cu); per_cu = 1; }
        (void)hipGetLastError();
        grid = cus;
        fprintf(stderr, "kernel_launch: grid %d (cus %d, per_cu %d), ws %zu\n", grid, cus, per_cu, ws_size);
    }
    if (grid < 0) return;
    (void)hipMemsetAsync((char*)d_ws + WS_CTL, 0, CTL_ZERO_BYTES, stream);
    Args a{};
    for (int i = 0; i < 28; ++i) a.in[i] = (const float*)d_in[i];
    a.out = (float*)d_out; a.ws = (unsigned char*)d_ws;
#if MK_N_LAUNCHES == 1
    a.ph_lo = 0; a.ph_hi = NPHASE;
    void* params[] = {&a};
    hipError_t e = hipLaunchCooperativeKernel((const void*)fwd_kernel, dim3(grid), dim3(NWAVES * 64), params, LDS_BYTES, stream);
    if (e != hipSuccess) fprintf(stderr, "kernel_launch: cooperative launch failed: %s\n", hipGetErrorString(e));
#else
    for (int p = 0; p < NPHASE; ++p) {
        a.ph_lo = p; a.ph_hi = p + 1;
        hipLaunchKernelGGL(fwd_kernel, dim3(grid), dim3(NWAVES * 64), LDS_BYTES, stream, a);
    }
#endif
}
```
